# Optimizing an MI355X kernel written in HIP

```python
import math
import jax, jax.numpy as jnp
from jax import lax
import numpy as np

D_MODEL = 1024
BATCH = 16
SEQ = 2048
DEPTH = 4
DEC_BATCH = 16
DEC_SEQ = 4096
PAST_LEN = 128

MIX_WIDTH = 2 * D_MODEL
W_A = MIX_WIDTH // 2
W_B = MIX_WIDTH - W_A
CHUNK = 128
A_HEADS = 4
A_HEAD_DIM = W_A // A_HEADS
B_GROUP_CH = 16
B_GROUPS = W_B // B_GROUP_CH
B_STATE = 64
N_DIR = 2
PROJ_COLS = 3 * W_A + 2 * W_B
EPS = 1e-6
DT_MIN = 1e-3
DT_MAX = 1e-1

kernel_name = "hymba_gmlp_s5_bidir_encoder"


def rmsnorm(x, g):
    xf = x.astype(jnp.float32)
    y = xf * lax.rsqrt(jnp.mean(xf * xf, axis=-1, keepdims=True) + EPS)
    return (y * g.astype(jnp.float32)).astype(x.dtype)


def layernorm(x, g, b):
    xf = x.astype(jnp.float32)
    mu = jnp.mean(xf, axis=-1, keepdims=True)
    xc = xf - mu
    y = xc * lax.rsqrt(jnp.mean(xc * xc, axis=-1, keepdims=True) + EPS)
    return (y * g.astype(jnp.float32) + b.astype(jnp.float32)).astype(x.dtype)


def gmlp_branch(u, v, z, ln_g, ln_b, w_s, b_s):
    n, l, _ = u.shape
    v = layernorm(v, ln_g, ln_b)
    vh = v.reshape(n, l // CHUNK, CHUNK, A_HEADS, A_HEAD_DIM)
    sv = jnp.einsum('hpq,ncqhd->ncphd', w_s, vh) + b_s.T[None, None, :, :, None]
    return u * sv.reshape(n, l, W_A) * jax.nn.silu(z)


def _cmul_combine(e1, e2):
    a1r, a1i, b1r, b1i = e1
    a2r, a2i, b2r, b2i = e2
    ar = a2r * a1r - a2i * a1i
    ai = a2r * a1i + a2i * a1r
    br = a2r * b1r - a2i * b1i + b2r
    bi = a2r * b1i + a2i * b1r + b2i
    return (ar, ai, br, bi)


def s5_direction(xg, lam_re, lam_im, log_dt, b_re, b_im, c_re, c_im):
    n, l, g, c = xg.shape
    lam_re = lam_re.astype(jnp.float32)
    lam_im = lam_im.astype(jnp.float32)
    dt = jnp.exp(log_dt.astype(jnp.float32))[:, None]
    mag = jnp.exp(lam_re * dt)
    ar = mag * jnp.cos(lam_im * dt)
    ai = mag * jnp.sin(lam_im * dt)
    nr, ni = ar - 1.0, ai
    den = lam_re * lam_re + lam_im * lam_im
    fr = (nr * lam_re + ni * lam_im) / den
    fi = (ni * lam_re - nr * lam_im) / den
    b_re = b_re.astype(jnp.float32)
    b_im = b_im.astype(jnp.float32)
    bb_re = fr[..., None] * b_re - fi[..., None] * b_im
    bb_im = fr[..., None] * b_im + fi[..., None] * b_re
    c_re = c_re.astype(jnp.float32)
    c_im = c_im.astype(jnp.float32)
    t = jnp.arange(1, CHUNK + 1, dtype=jnp.float32)[:, None, None]
    pmag = jnp.exp(t * lam_re * dt)
    pr = pmag * jnp.cos(t * lam_im * dt)
    pi = pmag * jnp.sin(t * lam_im * dt)
    xc = xg.reshape(n, l // CHUNK, CHUNK, g, c).transpose(1, 0, 2, 3, 4)

    def step(h, xk):
        hr, hi = h
        bu_r = jnp.einsum('ntgc,gpc->ntgp', xk, bb_re)
        bu_i = jnp.einsum('ntgc,gpc->ntgp', xk, bb_im)
        a_r = jnp.broadcast_to(ar, bu_r.shape)
        a_i = jnp.broadcast_to(ai, bu_i.shape)
        _, _, sr, si = lax.associative_scan(_cmul_combine, (a_r, a_i, bu_r, bu_i), axis=1)
        sr = sr + pr * hr[:, None] - pi * hi[:, None]
        si = si + pr * hi[:, None] + pi * hr[:, None]
        y = jnp.einsum('ntgp,gcp->ntgc', sr, c_re) - jnp.einsum('ntgp,gcp->ntgc', si, c_im)
        return (sr[:, -1], si[:, -1]), y

    h0 = (jnp.zeros((n, g, B_STATE), jnp.float32), jnp.zeros((n, g, B_STATE), jnp.float32))
    _, y = lax.scan(step, h0, xc)
    return y.transpose(1, 0, 2, 3, 4).reshape(n, l, g, c)


def s5_branch(xb, z, lam_re, lam_im, log_dt, b_re, b_im, c_re, c_im, d_skip, w_glu, b_glu):
    n, l, _ = xb.shape
    xg = xb.astype(jnp.float32).reshape(n, l, B_GROUPS, B_GROUP_CH)
    y_fwd = s5_direction(xg, lam_re[0], lam_im[0], log_dt[0], b_re[0], b_im[0], c_re[0], c_im[0])
    y_bwd = jnp.flip(s5_direction(jnp.flip(xg, axis=1), lam_re[1], lam_im[1], log_dt[1],
                                  b_re[1], b_im[1], c_re[1], c_im[1]), axis=1)
    y = ((y_fwd + y_bwd).reshape(n, l, W_B)).astype(xb.dtype) + d_skip * xb
    gy = jax.nn.gelu(y)
    gy = gy * jax.nn.sigmoid(gy @ w_glu + b_glu)
    return gy * jax.nn.silu(z)


def trunk(x, norm_g, w_in, ln_g, ln_b, w_s, b_s, lam_re, lam_im, log_dt,
          b_re, b_im, c_re, c_im, d_skip, w_glu, b_glu, w_out, final_g):
    splits = [W_A, 2 * W_A, 3 * W_A, 3 * W_A + W_B]
    for i in range(DEPTH):
        h = rmsnorm(x, norm_g[i])
        proj = h @ w_in[i]
        u_a, v_a, z_a, x_b, z_b = jnp.split(proj, splits, axis=-1)
        y_a = gmlp_branch(jax.nn.gelu(u_a), jax.nn.gelu(v_a), z_a, ln_g[i], ln_b[i], w_s[i], b_s[i])
        y_b = s5_branch(x_b, z_b, lam_re[i], lam_im[i], log_dt[i], b_re[i], b_im[i],
                        c_re[i], c_im[i], d_skip[i], w_glu[i], b_glu[i])
        x = x + jnp.concatenate([y_a, y_b], axis=-1) @ w_out[i]
    return rmsnorm(x, final_g)


def setup_inputs(seed: int = 0) -> dict:
    key = jax.random.key(seed)
    ks = jax.random.split(key, 24)
    f32 = jnp.float32
    x_prompt = jax.random.normal(ks[0], (BATCH, SEQ, D_MODEL), f32)
    x_sample = jax.random.normal(ks[1], (DEC_BATCH, DEC_SEQ, D_MODEL), f32)
    norm_g = 1.0 + 0.05 * jax.random.normal(ks[2], (DEPTH, D_MODEL), f32)
    w_in = jax.random.normal(ks[3], (DEPTH, D_MODEL, PROJ_COLS), f32) * D_MODEL ** -0.5
    ln_g = 1.0 + 0.05 * jax.random.normal(ks[4], (DEPTH, W_A), f32)
    ln_b = 0.02 * jax.random.normal(ks[5], (DEPTH, W_A), f32)
    w_s = jax.random.normal(ks[6], (DEPTH, A_HEADS, CHUNK, CHUNK), f32) * CHUNK ** -0.5
    b_s = 1.0 + 0.1 * jax.random.normal(ks[7], (DEPTH, A_HEADS, CHUNK), f32)
    shp = (DEPTH, N_DIR, B_GROUPS, B_STATE)
    lam_re = -0.5 + 0.01 * jax.random.normal(ks[8], shp, f32)
    lam_im = math.pi * jnp.arange(B_STATE, dtype=f32) + 0.01 * jax.random.normal(ks[9], shp, f32)
    log_dt = jax.random.uniform(ks[10], (DEPTH, N_DIR, B_GROUPS), f32,
                                math.log(DT_MIN), math.log(DT_MAX))
    bshp = (DEPTH, N_DIR, B_GROUPS, B_STATE, B_GROUP_CH)
    b_re = jax.random.normal(ks[11], bshp, f32) * (2 * B_GROUP_CH) ** -0.5
    b_im = jax.random.normal(ks[12], bshp, f32) * (2 * B_GROUP_CH) ** -0.5
    cshp = (DEPTH, N_DIR, B_GROUPS, B_GROUP_CH, B_STATE)
    c_re = jax.random.normal(ks[13], cshp, f32) * (2 * B_STATE) ** -0.5
    c_im = jax.random.normal(ks[14], cshp, f32) * (2 * B_STATE) ** -0.5
    d_skip = jax.random.normal(ks[15], (DEPTH, W_B), f32)
    w_glu = jax.random.normal(ks[16], (DEPTH, W_B, W_B), f32) * W_B ** -0.5
    b_glu = 0.02 * jax.random.normal(ks[17], (DEPTH, W_B), f32)
    w_out = jax.random.normal(ks[18], (DEPTH, MIX_WIDTH, D_MODEL), f32) * MIX_WIDTH ** -0.5
    final_g = 1.0 + 0.05 * jax.random.normal(ks[19], (D_MODEL,), f32)
    return {"x_prompt": x_prompt, "x_sample": x_sample, "norm_g": norm_g, "w_in": w_in,
            "ln_g": ln_g, "ln_b": ln_b, "w_s": w_s, "b_s": b_s,
            "lam_re": lam_re, "lam_im": lam_im, "log_dt": log_dt,
            "b_re": b_re, "b_im": b_im, "c_re": c_re, "c_im": c_im,
            "d_skip": d_skip, "w_glu": w_glu, "b_glu": b_glu, "w_out": w_out,
            "final_g": final_g}


def reference(x_prompt, x_sample, norm_g, w_in, ln_g, ln_b, w_s, b_s, lam_re, lam_im, log_dt,
              b_re, b_im, c_re, c_im, d_skip, w_glu, b_glu, w_out, final_g):
    y_prompt = trunk(x_prompt, norm_g, w_in, ln_g, ln_b, w_s, b_s, lam_re, lam_im, log_dt,
                     b_re, b_im, c_re, c_im, d_skip, w_glu, b_glu, w_out, final_g)
    y_sample = trunk(x_sample, norm_g, w_in, ln_g, ln_b, w_s, b_s, lam_re, lam_im, log_dt,
                     b_re, b_im, c_re, c_im, d_skip, w_glu, b_glu, w_out, final_g)
    return (y_prompt, y_sample)
```

```cpp
#include <hip/hip_runtime.h>
#include <cstdio>
#include <cstdint>

#ifndef DUP
#define DUP 0
#endif
#ifndef PA_WGM
#define PA_WGM 8
#endif
#ifndef MK_ONE_LAUNCH
#define MK_ONE_LAUNCH 1
#endif

#define LAS __attribute__((address_space(3)))
typedef unsigned short bf16_t;
typedef short bf16x8 __attribute__((ext_vector_type(8)));
typedef float f32x4 __attribute__((ext_vector_type(4)));
typedef float f32x2 __attribute__((ext_vector_type(2)));
typedef unsigned u32x4 __attribute__((ext_vector_type(4)));
typedef unsigned u32x2 __attribute__((ext_vector_type(2)));

constexpr int D = 1024, DEPTH = 4, TALL = 98304, TP = 98304  , TPROMPT = 32768, QC = 32, NCH = TP / QC  ;
constexpr int NIN = 5120, XSK = 768  ;
constexpr float EPS = 1e-6f;
constexpr int GRID = 256, NTHR = 512;
constexpr int NSTEPS = 1 + DEPTH * 5 + 1;

constexpr size_t MiB = 1u << 20, KiB = 1u << 10;
constexpr size_t WS_BAR = 0;
constexpr size_t WS_SSQ = 64 * KiB;
constexpr size_t WS_VSUM = WS_SSQ + (size_t)(DEPTH + 1) * TP * 8;
constexpr size_t WS_VSQ = WS_VSUM + (size_t)DEPTH * TP * 8;
constexpr size_t ZERO_BYTES = WS_VSQ + (size_t)DEPTH * TP * 8;
static_assert(ZERO_BYTES % 16 == 0 && ZERO_BYTES <= 11 * MiB, "zero region");
constexpr size_t WS_VEC = 11 * MiB;
constexpr int VEC_LNG = 0, VEC_LNB = 4096, VEC_BGLU = 8192, VEC_BS = 12288, VEC_FG = 14336, VEC_N = 15360;
constexpr size_t WS_AQ = 11 * MiB + 512 * KiB;
constexpr size_t WS_WSB = 12 * MiB;
constexpr size_t WS_WIN = 13 * MiB;
constexpr size_t WS_WGLU = 53 * MiB;
constexpr size_t WS_WOUT = 61 * MiB;
constexpr size_t WS_W1 = 77 * MiB;
constexpr size_t WS_W3 = 141 * MiB;
constexpr size_t WS_XB = 333 * MiB;
constexpr size_t WS_GV = 525 * MiB;
constexpr size_t WS_XS = 717 * MiB;
constexpr size_t WS_XF = WS_GV;
constexpr size_t WS_END = 1005 * MiB;
constexpr size_t WS_DUMMY = 1005 * MiB;

constexpr int LDS_BYTES = 151552;
constexpr int SLAB_OFF = 131072, SLAB_BYTES = 2304;
constexpr int MISC_OFF = LDS_BYTES - 256;

__device__ __forceinline__ unsigned cvt_pk_bf16(float lo, float hi) { unsigned r; asm volatile("v_cvt_pk_bf16_f32 %0, %1, %2" : "=v"(r) : "v"(lo), "v"(hi)); return r; }
__device__ __forceinline__ float bf_lo(unsigned w) { return __uint_as_float(w << 16); }
__device__ __forceinline__ float bf_hi(unsigned w) { return __uint_as_float(w & 0xffff0000u); }
__device__ __forceinline__ float bf2f(bf16_t b) { return __uint_as_float(((unsigned)b) << 16); }
__device__ __forceinline__ bf16_t f2bf(float f) { return (bf16_t)(cvt_pk_bf16(f, 0.f) & 0xffffu); }
__device__ __forceinline__ float fexp2(float x) { return __builtin_amdgcn_exp2f(x); }
__device__ __forceinline__ float frcp(float x) { return __builtin_amdgcn_rcpf(x); }
__device__ __forceinline__ float gelu_t(float x) {
    const float u = x * (1.0f + 0.044715f * x * x);
    return x * frcp(1.0f + fexp2(u * (-2.0f * 0.7978845608f * 1.4426950409f)));
}
__device__ __forceinline__ float sigmoid_f(float z) { return frcp(1.0f + fexp2(z * -1.4426950409f)); }
#ifndef ST_POLICY
#define ST_POLICY 0
#endif
__device__ __forceinline__ void st16(void* p, u32x4 v) {
#if ST_POLICY == 1
    __builtin_nontemporal_store(v, (u32x4*)p);
#else
    *(u32x4*)p = v;
#endif
}
__device__ __forceinline__ void stage_store16(LAS unsigned char* slab, int fr, int fq, u32x4 w0, u32x4 w1, bf16_t* row0, size_t ld) {
    *(LAS u32x4*)(slab + fr * 144 + fq * 16) = w0; *(LAS u32x4*)(slab + fr * 144 + 64 + fq * 16) = w1;
    asm volatile("s_waitcnt lgkmcnt(0)" ::: "memory");
    const int l = fq * 16 + fr;
    const u32x4 a = *(const LAS u32x4*)(slab + (l >> 3) * 144 + (l & 7) * 16), b = *(const LAS u32x4*)(slab + (8 + (l >> 3)) * 144 + (l & 7) * 16);
    asm volatile("s_waitcnt lgkmcnt(0)" ::: "memory");
    st16(row0 + (size_t)(l >> 3) * ld + (l & 7) * 8, a); st16(row0 + (size_t)(8 + (l >> 3)) * ld + (l & 7) * 8, b);
}
typedef unsigned long long u64;
constexpr float FX_SSQ = 16777216.0f  , FX_V = 4294967296.0f  ;
__device__ __forceinline__ u64 to_fx(float v, float scale) { return (u64)(long long)(v * scale); }
__device__ __forceinline__ float from_fx(u64 x, float inv_scale) { return (float)(long long)x * inv_scale; }
__device__ __forceinline__ float rstd_of(u64 ssq_fx) { return rsqrtf(from_fx(ssq_fx, (1.0f / FX_SSQ) * (1.0f / 1024.0f)) + EPS); }
__device__ __forceinline__ float wave_sum(float v) {
#pragma unroll
    for (int o = 1; o < 64; o <<= 1) v += __shfl_xor(v, o);
    return v;
}

__device__ __forceinline__ int lane_id() { int l; asm volatile("v_mbcnt_lo_u32_b32 %0, -1, 0\n\tv_mbcnt_hi_u32_b32 %0, -1, %0" : "=v"(l)); return l; }
__device__ __forceinline__ int opaque_tid(int wv) { int t = wv * 64 + lane_id(); asm volatile("" : "+v"(t)); return t; }
__device__ __forceinline__ int opaque_bid() { int b = blockIdx.x; asm volatile("" : "+s"(b)); return b; }

#define XB_TMO      128
#define XB_XCNT(j)  (256  + 64 * (j))
#define XB_XSUB(j)  (1280 + 64 * (j))
#define XB_XGEN(j)  (2304 + 64 * (j))
#define XB_TOP      3328
#define XB_TOPGEN   3392
#define XCD_BAR_WORDS 3456
#define XB_SPIN_CAP (1u << 18)
__device__ __forceinline__ unsigned xb_ld(unsigned* p)              { return __hip_atomic_load(p, __ATOMIC_RELAXED, __HIP_MEMORY_SCOPE_AGENT); }
__device__ __forceinline__ unsigned xb_add(unsigned* p, unsigned v) { return __hip_atomic_fetch_add(p, v, __ATOMIC_RELAXED, __HIP_MEMORY_SCOPE_AGENT); }
__device__ __forceinline__ unsigned xb_xcc_id() { return (unsigned)__builtin_amdgcn_s_getreg((3 << 11) | 20) & 0xFu; }
#define XB_SPIN(cond, bar) do { unsigned _sp = 0; while (cond) { __builtin_amdgcn_s_sleep(1); \
    if ((++_sp & 255u) == 0u) { if (xb_ld(&(bar)[XB_TMO])) break; if (_sp > XB_SPIN_CAP) { atomicAdd(&(bar)[XB_TMO], 1u); break; } } } } while (0)
struct XcdBarrier { unsigned* bar; unsigned x; volatile LAS unsigned* st; int wv; };
__device__ __forceinline__ XcdBarrier xcd_barrier_post(unsigned* bar, volatile LAS unsigned* st) {
    XcdBarrier b; b.bar = bar; b.x = xb_xcc_id(); b.st = st; b.wv = 0;
    if (threadIdx.x == 0) (void)xb_add(&bar[XB_XCNT(b.x)], 1u);
    return b;
}
__device__ __forceinline__ void xcd_barrier_complete(unsigned* bar, unsigned x, unsigned& nloc, unsigned& nx) {
    const unsigned G = gridDim.x * gridDim.y * gridDim.z;
    unsigned sum, cnt, mine, sp = 0u;
    for (;;) {
        sum = 0u; cnt = 0u; mine = 0u;
#pragma unroll
        for (unsigned j = 0; j < 16; ++j) { const unsigned c = xb_ld(&bar[XB_XCNT(j)]); sum += c; cnt += (c > 0u) ? 1u : 0u; mine = (j == x) ? c : mine; }
        if (sum == G) break;
        __builtin_amdgcn_s_sleep(1);
        if ((++sp & 255u) == 0u) { if (xb_ld(&bar[XB_TMO])) break; if (sp > XB_SPIN_CAP) { atomicAdd(&bar[XB_TMO], 1u); break; } }
    }
    nloc = mine > 0u ? mine : 1u; nx = cnt > 0u ? cnt : 1u;
}
__device__ __forceinline__ void xcd_barrier(const XcdBarrier& b) {
    asm volatile("s_waitcnt vmcnt(0)" ::: "memory");
    __syncthreads();
    if (b.wv == 0 && lane_id() == 0) {
        unsigned* bar = b.bar;
        __builtin_amdgcn_s_waitcnt(0);
        unsigned nloc = b.st[0], nx = b.st[1];
        if (nloc == 0u) { xcd_barrier_complete(bar, b.x, nloc, nx); b.st[0] = nloc; b.st[1] = nx; }
        const unsigned old = xb_add(&bar[XB_XSUB(b.x)], 1u);
        const unsigned gen = old / nloc;
        if (old + 1u == (gen + 1u) * nloc) {
            __builtin_amdgcn_fence(__ATOMIC_RELEASE, "agent");
            asm volatile("s_waitcnt vmcnt(0)" ::: "memory");
            const unsigned og = xb_add(&bar[XB_TOP], 1u);
            const unsigned tg = og / nx;
            if (og + 1u == (tg + 1u) * nx) xb_add(&bar[XB_TOPGEN], 1u);
            else XB_SPIN(xb_ld(&bar[XB_TOPGEN]) == tg, bar);
            __builtin_amdgcn_fence(__ATOMIC_ACQUIRE, "agent");
            xb_add(&bar[XB_XGEN(b.x)], 1u);
            asm volatile("s_waitcnt vmcnt(0)" ::: "memory");
        } else {
            XB_SPIN(xb_ld(&bar[XB_XGEN(b.x)]) == gen, bar);
            __builtin_amdgcn_fence(__ATOMIC_ACQUIRE, "agent");
            asm volatile("s_waitcnt vmcnt(0)" ::: "memory");
        }
    }
    __syncthreads();
}

namespace pg8 {
constexpr int BM = 256, BK = 64, HALF = 128, HTB = HALF * BK * 2, STAGE_BYTES = 8 * HTB, NXCD = 8, WGM = 8;
__host__ __device__ __forceinline__ int lds_byte(int r, int c) { const int st = (r >> 4) * 2 + (c >> 5), rr = r & 15, cc = c & 31, ob = rr * 64 + cc * 2; return st * 1024 + (ob ^ (((ob >> 9) & 1) << 5)); }
__host__ __device__ __forceinline__ void stage_rc(int b, int& R, int& C) { const int st = b / 1024, sb = b % 1024, swz = sb ^ (((sb >> 9) & 1) << 5); R = (st >> 1) * 16 + swz / 64; C = (st & 1) * 32 + (swz % 64) / 2; }
__host__ __device__ __forceinline__ int perm32(int rho) { const int n = rho >> 4, i = rho & 15; return 8 * (i >> 2) + 4 * n + (i & 3); }

struct Unit { int pm, pn, g; };
struct GOp { const char* base; unsigned rs, cs; size_t kstep, gstride; };

struct SchedStd {
    int nM, nN, nwg, G, c, wgm;
    __device__ __forceinline__ void init(int M, int N, int G_, int c_, int wgm_ = WGM) { nM = M / BM; nN = N / BM; nwg = nM * nN; G = G_; c = c_; wgm = wgm_; }
    __device__ __forceinline__ bool next(int i, Unit& u) const {
        const long L = (long)i * G + c; if (L >= nwg) return false;
        int wgid = (int)L; { const int q = nwg / NXCD, r = nwg % NXCD, xcd = wgid % NXCD, off = wgid / NXCD; wgid = (xcd < r ? xcd * (q + 1) : r * (q + 1) + (xcd - r) * q) + off; }
        const int nig = wgm * nN, gid = wgid / nig, fm = gid * wgm, gsz = (nM - fm) < wgm ? (nM - fm) : wgm;
        u.pm = fm + ((wgid % nig) % gsz); u.pn = (wgid % nig) / gsz; u.g = 0; return true;
    }
};
struct SchedWrap : SchedStd { __device__ __forceinline__ bool next(int i, Unit& u) const { const bool ok = SchedStd::next(i, u); u.pm &= 15; return ok; } };
struct SchedBatch {
    int nN, per, nwg, G, c;
    __device__ __forceinline__ void init(int ng, int nM_, int nN_, int G_, int c_) { nN = nN_; per = nM_ * nN_; nwg = ng * per; G = G_; c = c_; }
    __device__ __forceinline__ bool next(int i, Unit& u) const {
        const long L = (long)i * G + c; if (L >= nwg) return false;
        const int w = (int)(L % NXCD) * (nwg / NXCD) + (int)(L / NXCD);
        u.g = w / per; const int r = w % per; u.pm = r / nN; u.pn = r % nN; return true;
    }
};

struct SchedOne { Unit u; __device__ __forceinline__ bool next(int i, Unit& o) const { if (i > 0) return false; o = u; return true; } };

template <class Epi, class Sched>
__device__ __forceinline__ void gemm_phase(LAS unsigned char* lds, const GOp A, const GOp B, const int nt, const Sched& S, const Epi& E, const int wv) {
    const int tid = opaque_tid(wv), wid = __builtin_amdgcn_readfirstlane(tid >> 6), lane = tid & 63, wr = wid >> 2, wc = wid & 3, fr = lane & 15, fq = lane >> 4;
    unsigned voffA[2], voffB[2];
#pragma unroll
    for (int i = 0; i < 2; ++i) { int R, C; stage_rc(tid * 16 + i * 8192, R, C);
        const int Rb = Epi::NC ? (64 * (R >> 5) + perm32(R & 31)) : ((R & ~31) + perm32(R & 31));
        voffA[i] = (unsigned)R * A.rs + (unsigned)(C >> 4) * A.cs + (unsigned)(C & 15) * 2u;
        voffB[i] = (unsigned)Rb * B.rs + (unsigned)(C >> 4) * B.cs + (unsigned)(C & 15) * 2u; }
    const size_t kstepA = A.kstep, kstepB = B.kstep;
    const size_t hstepA = (size_t)HALF * A.rs, hstepB = (size_t)(Epi::NC ? 32 : HALF) * B.rs;
    const size_t tstepA = 2 * hstepA, tstepB = (size_t)BM * B.rs;
    const unsigned ldsw = (unsigned)wid * 1024u;
    const int aoff = lds_byte(wr * 64 + fr, fq * 8), boff = lds_byte(wc * 32 + fr, fq * 8);
#define PG8_SA(b, h) (((b) * 2 + (h)) * HTB)
#define PG8_SB(b, h) ((4 + (b) * 2 + (h)) * HTB)
#define PG8_STAGE(bufoff, gbase, voff) do { _Pragma("unroll") for (int _i = 0; _i < 2; ++_i) \
        __builtin_amdgcn_global_load_lds((const unsigned*)((const char*)(gbase) + (voff)[_i]), (LAS unsigned*)(lds + (bufoff) + ldsw + _i * 8192), 16, 0, 0); } while (0)
#define PG8_LDA(dst, b, h) do { _Pragma("unroll") for (int m = 0; m < 4; ++m) _Pragma("unroll") for (int k = 0; k < 2; ++k) dst[m][k] = *(const LAS bf16x8*)(lds + PG8_SA(b, h) + aoff + m * 2048 + k * 1024); } while (0)
#define PG8_LDB(dst, b, h) do { _Pragma("unroll") for (int n = 0; n < 2; ++n) _Pragma("unroll") for (int k = 0; k < 2; ++k) dst[n][k] = *(const LAS bf16x8*)(lds + PG8_SB(b, h) + boff + n * 2048 + k * 1024); } while (0)
#define PG8_MMA(ai, bj, At, Bt) do { __builtin_amdgcn_s_setprio(1); _Pragma("unroll") for (int m = 0; m < 4; ++m) _Pragma("unroll") for (int n = 0; n < 2; ++n) _Pragma("unroll") for (int k = 0; k < 2; ++k) \
        acc[ai][bj][m][n] = __builtin_amdgcn_mfma_f32_16x16x32_bf16(Bt[n][k], At[m][k], acc[ai][bj][m][n], 0, 0, 0); __builtin_amdgcn_s_setprio(0); } while (0)
#define PG8_WAIT_V(n) asm volatile("s_waitcnt vmcnt(" #n ")" ::: "memory")
#define PG8_WAIT_L(n) asm volatile("s_waitcnt lgkmcnt(" #n ")" ::: "memory")
#define PG8_BAR __builtin_amdgcn_s_barrier()
#define PG8_SCHED __builtin_amdgcn_sched_barrier(0)
    Unit cur, nxt; int ui = 0;
    if (!S.next(0, cur)) return;
    f32x4 acc[2][2][4][2];
#pragma unroll
    for (int a = 0; a < 2; ++a)
#pragma unroll
        for (int b = 0; b < 2; ++b)
#pragma unroll
            for (int m = 0; m < 4; ++m)
#pragma unroll
                for (int n = 0; n < 2; ++n) acc[a][b][m][n] = (f32x4){0.f, 0.f, 0.f, 0.f};
    bf16x8 At[4][2], B0[2][2], B1[2][2];
    const char* cA = A.base + (size_t)cur.g * A.gstride + (size_t)cur.pm * tstepA;
    const char* cB = B.base + (size_t)cur.g * B.gstride + (size_t)cur.pn * tstepB;
    PG8_STAGE(PG8_SB(0, 0), cB, voffB); PG8_STAGE(PG8_SB(0, 1), cB + hstepB, voffB); PG8_STAGE(PG8_SA(0, 0), cA, voffA); PG8_STAGE(PG8_SA(0, 1), cA + hstepA, voffA);
    if (wr == 1) PG8_BAR;
    PG8_WAIT_V(2); PG8_BAR;
    PG8_STAGE(PG8_SB(1, 0), cB + kstepB, voffB); PG8_STAGE(PG8_SA(1, 0), cA + kstepA, voffA); PG8_STAGE(PG8_SB(1, 1), cB + hstepB + kstepB, voffB);
    PG8_WAIT_V(6); PG8_BAR;
    for (;;) {
        const bool has_next = S.next(ui + 1, nxt);
        const char* nA = has_next ? A.base + (size_t)nxt.g * A.gstride + (size_t)nxt.pm * tstepA : cA;
        const char* nB = has_next ? B.base + (size_t)nxt.g * B.gstride + (size_t)nxt.pn * tstepB : cB;
        for (int t = 0; t < nt; t += 2) {
            const bool last = (t == nt - 2);
            const char* a1 = cA + (size_t)(t + 1) * kstepA;
            const char* a2 = last ? nA : cA + (size_t)(t + 2) * kstepA; const char* b2 = last ? nB : cB + (size_t)(t + 2) * kstepB;
            const char* a3 = a2 + kstepA; const char* b3 = b2 + kstepB;
            PG8_LDB(B0, 0, 0); PG8_LDB(B1, 0, 1); PG8_SCHED; PG8_LDA(At, 0, 0); PG8_STAGE(PG8_SA(1, 1), a1 + hstepA, voffA);
            PG8_WAIT_V(8); PG8_WAIT_L(0); PG8_BAR; PG8_MMA(0, 0, At, B0); PG8_MMA(0, 1, At, B1); PG8_BAR; PG8_SCHED;
            PG8_LDA(At, 0, 1); PG8_STAGE(PG8_SB(0, 0), b2, voffB); PG8_STAGE(PG8_SB(0, 1), b2 + hstepB, voffB); PG8_STAGE(PG8_SA(0, 0), a2, voffA);
            PG8_WAIT_V(8); PG8_WAIT_L(0); PG8_BAR; PG8_MMA(1, 0, At, B0); PG8_MMA(1, 1, At, B1); PG8_BAR; PG8_SCHED;
            PG8_LDB(B0, 1, 0); PG8_LDB(B1, 1, 1); PG8_SCHED; PG8_LDA(At, 1, 0); PG8_STAGE(PG8_SA(0, 1), a2 + hstepA, voffA);
            PG8_WAIT_V(8); PG8_WAIT_L(0); PG8_BAR; PG8_MMA(0, 0, At, B0); PG8_MMA(0, 1, At, B1); PG8_BAR; PG8_SCHED;
            PG8_LDA(At, 1, 1); PG8_STAGE(PG8_SB(1, 0), b3, voffB); PG8_STAGE(PG8_SB(1, 1), b3 + hstepB, voffB); PG8_STAGE(PG8_SA(1, 0), a3, voffA);
            PG8_WAIT_V(8); PG8_WAIT_L(0); PG8_BAR; PG8_MMA(1, 0, At, B0); PG8_MMA(1, 1, At, B1); PG8_BAR; PG8_SCHED;
        }
        if (wr == 0) PG8_BAR;
        if constexpr (!Epi::AFTER_DRAIN) E(acc, cur, wr, wc, fr, fq);
        if (!has_next) break;
#pragma unroll
        for (int a = 0; a < 2; ++a)
#pragma unroll
            for (int b = 0; b < 2; ++b)
#pragma unroll
                for (int m = 0; m < 4; ++m)
#pragma unroll
                    for (int n = 0; n < 2; ++n) acc[a][b][m][n] = (f32x4){0.f, 0.f, 0.f, 0.f};
        cur = nxt; cA = nA; cB = nB; ++ui;
        if (wr == 1) PG8_BAR;
    }
    PG8_WAIT_V(0);
    PG8_BAR;
    if constexpr (Epi::AFTER_DRAIN) E.fused(acc, cur, wr, wc, fr, fq, lds, tid);
#undef PG8_SA
#undef PG8_SB
#undef PG8_STAGE
#undef PG8_LDA
#undef PG8_LDB
#undef PG8_MMA
#undef PG8_WAIT_V
#undef PG8_WAIT_L
#undef PG8_BAR
#undef PG8_SCHED
}
}
using pg8::Unit;

typedef f32x4 AccT[2][2][4][2];

struct EpiNull {
    static constexpr bool PERM = true, AFTER_DRAIN = false, NC = true;
    __device__ __forceinline__ void operator()(const AccT& acc, const Unit& u, int wr, int wc, int fr, int fq) const {
#pragma unroll
        for (int ai = 0; ai < 2; ++ai)
#pragma unroll
            for (int bj = 0; bj < 2; ++bj)
#pragma unroll
                for (int m = 0; m < 4; ++m)
#pragma unroll
                    for (int n = 0; n < 2; ++n) asm volatile("" :: "v"(acc[ai][bj][m][n]));
    }
};

struct EpiInMain {
    static constexpr bool PERM = true, AFTER_DRAIN = false, NC = true;
    bf16_t* YC; bf16_t* XS; const u64* ssq; LAS unsigned char* lds;
    __device__ __forceinline__ void operator()(const AccT& acc, const Unit& u, int wr, int wc, int fr, int fq) const {
        const int rowb = u.pm * 256 + wr * 64 + fr;
        float rstd8[8];
        { u64 q8[8];
#pragma unroll
          for (int i = 0; i < 8; ++i) q8[i] = ssq[rowb + (i >> 2) * 128 + (i & 3) * 16];
#pragma unroll
          for (int i = 0; i < 8; ++i) rstd8[i] = rstd_of(q8[i]); }
        if (u.pn < 8) {
#pragma unroll
            for (int ai = 0; ai < 2; ++ai)
#pragma unroll
                for (int m = 0; m < 4; ++m) {
                    const int r = rowb + ai * 128 + m * 16;
                    const float rstd = rstd8[ai * 4 + m];
                    float o[8];
#pragma unroll
                    for (int n = 0; n < 2; ++n)
#pragma unroll
                        for (int j = 0; j < 4; ++j) {
                            const float uu = acc[ai][0][m][n][j] * rstd, zz = acc[ai][1][m][n][j] * rstd;
                            const float gu = uu * (1.0f + 0.044715f * uu * uu);
                            const float e1 = fexp2(gu * (-2.0f * 0.7978845608f * 1.4426950409f)), e2 = fexp2(zz * -1.4426950409f);
                            o[n * 4 + j] = (uu * zz) * frcp((1.0f + e1) * (1.0f + e2));
                        }
                    u32x4 w; w.x = cvt_pk_bf16(o[0], o[1]); w.y = cvt_pk_bf16(o[2], o[3]); w.z = cvt_pk_bf16(o[4], o[5]); w.w = cvt_pk_bf16(o[6], o[7]);
                    st16(YC + (size_t)r * 2048 + 128 * u.pn + 32 * wc + 8 * fq, w);
                }
        } else if (u.pn < 12) {
#pragma unroll
            for (int ai = 0; ai < 2; ++ai)
#pragma unroll
                for (int m = 0; m < 4; ++m) {
                    const int r = rowb + ai * 128 + m * 16;
                    const float rstd = rstd8[ai * 4 + m];
#pragma unroll
                    for (int bj = 0; bj < 2; ++bj) {
                        const int g = 16 * (u.pn - 8) + 4 * wc + 2 * bj + (fq >> 1);
                        const f32x4 v0 = acc[ai][bj][m][0] * rstd, v1 = acc[ai][bj][m][1] * rstd;
                        u32x4 w; w.x = cvt_pk_bf16(v0[0], v0[1]); w.y = cvt_pk_bf16(v0[2], v0[3]); w.z = cvt_pk_bf16(v1[0], v1[1]); w.w = cvt_pk_bf16(v1[2], v1[3]);
                        st16(XS + ((size_t)g * NCH + (r >> 5)) * XSK + (r & 31) * 16 + 8 * (fq & 1), w);
                    }
                }
        } else {
            LAS unsigned char* slab = lds + SLAB_OFF + (wr * 4 + wc) * SLAB_BYTES;
#pragma unroll
            for (int ai = 0; ai < 2; ++ai)
#pragma unroll
                for (int m = 0; m < 4; ++m) {
                    const float rstd = rstd8[ai * 4 + m];
                    u32x4 w[2];
#pragma unroll
                    for (int bj = 0; bj < 2; ++bj) {
                        float o[8];
#pragma unroll
                        for (int n = 0; n < 2; ++n)
#pragma unroll
                            for (int j = 0; j < 4; ++j) { const float zz = acc[ai][bj][m][n][j] * rstd; o[n * 4 + j] = zz * sigmoid_f(zz); }
                        w[bj].x = cvt_pk_bf16(o[0], o[1]); w[bj].y = cvt_pk_bf16(o[2], o[3]); w[bj].z = cvt_pk_bf16(o[4], o[5]); w[bj].w = cvt_pk_bf16(o[6], o[7]);
                    }
                    stage_store16(slab, fr, fq, w[0], w[1], YC + (size_t)(u.pm * 256 + wr * 64 + ai * 128 + m * 16) * 2048 + 1024 + 256 * (u.pn - 12) + 64 * wc, 2048);
                }
        }
    }
};

struct EpiInV {
    static constexpr bool PERM = true, AFTER_DRAIN = false, NC = true;
    bf16_t* GV; const u64* ssq; u64* vsum; u64* vsq; LAS unsigned char* lds;
    __device__ __forceinline__ void operator()(const AccT& acc, const Unit& u, int wr, int wc, int fr, int fq) const {
        f32x4 rs[2][2], s1[2][2], s2[2][2];
#pragma unroll
        for (int bj = 0; bj < 2; ++bj)
#pragma unroll
            for (int n = 0; n < 2; ++n) {
#pragma unroll
                for (int j = 0; j < 4; ++j) rs[bj][n][j] = rstd_of(ssq[u.pn * 256 + 64 * wc + 32 * bj + 8 * fq + 4 * n + j]);
                s1[bj][n] = (f32x4){0.f, 0.f, 0.f, 0.f}; s2[bj][n] = (f32x4){0.f, 0.f, 0.f, 0.f};
            }
        LAS unsigned char* slab = lds + SLAB_OFF + (wr * 4 + wc) * SLAB_BYTES;
#pragma unroll
        for (int ai = 0; ai < 2; ++ai)
#pragma unroll
            for (int m = 0; m < 4; ++m) {
                u32x4 w[2];
#pragma unroll
                for (int bj = 0; bj < 2; ++bj) {
                    f32x4 v[2];
#pragma unroll
                    for (int n = 0; n < 2; ++n) {
#pragma unroll
                        for (int j = 0; j < 4; ++j) v[n][j] = gelu_t(acc[ai][bj][m][n][j] * rs[bj][n][j]);
                        s1[bj][n] += v[n]; s2[bj][n] += v[n] * v[n];
                    }
                    w[bj].x = cvt_pk_bf16(v[0][0], v[0][1]); w[bj].y = cvt_pk_bf16(v[0][2], v[0][3]); w[bj].z = cvt_pk_bf16(v[1][0], v[1][1]); w[bj].w = cvt_pk_bf16(v[1][2], v[1][3]);
                }
                stage_store16(slab, fr, fq, w[0], w[1], GV + (size_t)(u.pm * 256 + ai * 128 + wr * 64 + m * 16) * TP + u.pn * 256 + 64 * wc, TP);
            }
        float v1[16], v2[16];
#pragma unroll
        for (int i = 0; i < 16; ++i) { v1[i] = s1[i >> 3][(i >> 2) & 1][i & 3]; v2[i] = s2[i >> 3][(i >> 2) & 1][i & 3]; }
#define RS_STEP(K) { const bool up = (fr & (K)) != 0; _Pragma("unroll") for (int i = 0; i < (K); ++i) { \
            const float k1 = up ? v1[i + (K)] : v1[i], g1 = up ? v1[i] : v1[i + (K)], k2 = up ? v2[i + (K)] : v2[i], g2 = up ? v2[i] : v2[i + (K)]; \
            v1[i] = k1 + __shfl_xor(g1, (K)); v2[i] = k2 + __shfl_xor(g2, (K)); } }
        RS_STEP(8) RS_STEP(4) RS_STEP(2) RS_STEP(1)
#undef RS_STEP
        { const int t = u.pn * 256 + 64 * wc + 32 * (fr >> 3) + 8 * fq + 4 * ((fr >> 2) & 1) + (fr & 3); atomicAdd(vsum + t, to_fx(v1[0], FX_V)); atomicAdd(vsq + t, to_fx(v2[0], FX_V)); }
    }
};

template <int ACT> struct EpiBf16 {
    static constexpr bool PERM = true, AFTER_DRAIN = false, NC = true;
    bf16_t* O; int ldc; size_t gstride; LAS unsigned char* lds;
    __device__ __forceinline__ void operator()(const AccT& acc, const Unit& u, int wr, int wc, int fr, int fq) const {
        bf16_t* base = O + (size_t)u.g * gstride + (size_t)(u.pm * 256 + wr * 64) * ldc + u.pn * 256 + 64 * wc;
        LAS unsigned char* slab = lds + SLAB_OFF + (wr * 4 + wc) * SLAB_BYTES;
#pragma unroll
        for (int ai = 0; ai < 2; ++ai)
#pragma unroll
            for (int m = 0; m < 4; ++m) {
                u32x4 w[2];
#pragma unroll
                for (int bj = 0; bj < 2; ++bj) {
                    f32x4 v0 = acc[ai][bj][m][0], v1 = acc[ai][bj][m][1];
                    if (ACT == 1) {
#pragma unroll
                        for (int j = 0; j < 4; ++j) { v0[j] = gelu_t(v0[j]); v1[j] = gelu_t(v1[j]); }
                    }
                    w[bj].x = cvt_pk_bf16(v0[0], v0[1]); w[bj].y = cvt_pk_bf16(v0[2], v0[3]); w[bj].z = cvt_pk_bf16(v1[0], v1[1]); w[bj].w = cvt_pk_bf16(v1[2], v1[3]);
                }
                stage_store16(slab, fr, fq, w[0], w[1], base + (size_t)(ai * 128 + m * 16) * ldc, (size_t)ldc);
            }
    }
};

struct EpiS1Scan {
    static constexpr bool PERM = true, AFTER_DRAIN = true, NC = false;
    bf16_t* XS; const float* AQ;
    __device__ __forceinline__ void fused(const AccT& acc, const Unit& u, int wr, int wc, int fr, int fq, LAS unsigned char* lds, int tid) const {
        LAS float* S = (LAS float*)lds;
        LAS f32x2* EE = (LAS f32x2*)(lds + 256 * 132 * 4);
        const int cps = u.pm < (TPROMPT / QC / 256) ? 64 : 128;
        const int p = tid & 63, seg = tid >> 6, nsps = cps >> 5, sidx = seg & (nsps - 1), seg0 = seg - sidx;
#pragma unroll
        for (int dir = 0; dir < 2; ++dir) {
#pragma unroll
            for (int ai = 0; ai < 2; ++ai)
#pragma unroll
                for (int m = 0; m < 4; ++m)
#pragma unroll
                    for (int n = 0; n < 2; ++n) *(LAS f32x4*)(S + (128 * ai + 64 * wr + 16 * m + fr) * 132 + 32 * wc + 8 * fq + 4 * n) = acc[ai][dir][m][n];
            asm volatile("s_waitcnt lgkmcnt(0)" ::: "memory"); __builtin_amdgcn_s_barrier(); asm volatile("" ::: "memory");
            const float ar = AQ[((u.g * 2 + dir) * 64 + p) * 2], ai_ = AQ[((u.g * 2 + dir) * 64 + p) * 2 + 1];
            float lr[32], li[32];
#pragma unroll
            for (int i = 0; i < 32; ++i) { const int cix = 32 * seg + (dir ? 31 - i : i); lr[i] = S[cix * 132 + p]; li[i] = S[cix * 132 + 64 + p]; }
            float er = 0.f, ei = 0.f;
#pragma unroll
            for (int i = 0; i < 32; ++i) { const float nr = ar * er - ai_ * ei + lr[i], ni = ar * ei + ai_ * er + li[i]; er = nr; ei = ni; }
            EE[seg * 64 + p] = (f32x2){er, ei};
            float br = ar, bi = ai_;
#pragma unroll
            for (int k = 0; k < 5; ++k) { const float nr = br * br - bi * bi, ni = 2.f * br * bi; br = nr; bi = ni; }
            asm volatile("s_waitcnt lgkmcnt(0)" ::: "memory"); __builtin_amdgcn_s_barrier(); asm volatile("" ::: "memory");
            float sr = 0.f, si = 0.f;
            const int nprev = dir ? (nsps - 1 - sidx) : sidx;
            for (int k = 0; k < nprev; ++k) { const int s2 = dir ? (seg0 + nsps - 1 - k) : (seg0 + k); const f32x2 e = EE[s2 * 64 + p];
                const float nr = br * sr - bi * si + e.x, ni = br * si + bi * sr + e.y; sr = nr; si = ni; }
            unsigned* xp = (unsigned*)(XS + ((size_t)u.g * NCH + (size_t)u.pm * 256 + 32 * seg) * XSK + 512 + dir * 128) + p;
#pragma unroll
            for (int i = 0; i < 32; ++i) { const int cl = dir ? 31 - i : i;
                xp[(size_t)cl * (XSK / 2)] = cvt_pk_bf16(sr, si);
                const float nr = ar * sr - ai_ * si + lr[i], ni = ar * si + ai_ * sr + li[i]; sr = nr; si = ni; }
            asm volatile("s_waitcnt lgkmcnt(0)" ::: "memory"); __builtin_amdgcn_s_barrier(); asm volatile("" ::: "memory");
        }
    }
};

struct EpiGlu {
    static constexpr bool PERM = true, AFTER_DRAIN = false, NC = true;
    const bf16_t* GY; bf16_t* YC; const float* bglu; LAS unsigned char* lds;
    __device__ __forceinline__ void operator()(const AccT& acc, const Unit& u, int wr, int wc, int fr, int fq) const {
        const int rowb = u.pm * 256 + wr * 64 + fr, cw = u.pn * 256 + 64 * wc;
        LAS unsigned char* slab = lds + SLAB_OFF + (wr * 4 + wc) * SLAB_BYTES;
        f32x4 bb[2][2];
#pragma unroll
        for (int bj = 0; bj < 2; ++bj) { bb[bj][0] = *(const f32x4*)(bglu + cw + 32 * bj + 8 * fq); bb[bj][1] = *(const f32x4*)(bglu + cw + 32 * bj + 8 * fq + 4); }
#pragma unroll
        for (int ai = 0; ai < 2; ++ai)
#pragma unroll
            for (int mp = 0; mp < 2; ++mp) {
                u32x4 gy[2][2], sz[2][2];
#pragma unroll
                for (int mm = 0; mm < 2; ++mm)
#pragma unroll
                    for (int bj = 0; bj < 2; ++bj) { const int r = rowb + ai * 128 + (2 * mp + mm) * 16, c0 = cw + 32 * bj + 8 * fq;
                        gy[mm][bj] = *(const u32x4*)(GY + ((size_t)(c0 >> 4) * TP + r) * 16 + (c0 & 15));
                        sz[mm][bj] = *(const u32x4*)(YC + (size_t)r * 2048 + 1024 + c0); }
                asm volatile("" ::: "memory");
#pragma unroll
                for (int mm = 0; mm < 2; ++mm) { const int m = 2 * mp + mm;
                    u32x4 w[2];
#pragma unroll
                    for (int bj = 0; bj < 2; ++bj) {
                        const f32x4 a0 = acc[ai][bj][m][0] + bb[bj][0], a1 = acc[ai][bj][m][1] + bb[bj][1]; const u32x4 g = gy[mm][bj], s = sz[mm][bj];
                        float o[8];
                        o[0] = bf_lo(g.x) * sigmoid_f(a0[0]) * bf_lo(s.x); o[1] = bf_hi(g.x) * sigmoid_f(a0[1]) * bf_hi(s.x);
                        o[2] = bf_lo(g.y) * sigmoid_f(a0[2]) * bf_lo(s.y); o[3] = bf_hi(g.y) * sigmoid_f(a0[3]) * bf_hi(s.y);
                        o[4] = bf_lo(g.z) * sigmoid_f(a1[0]) * bf_lo(s.z); o[5] = bf_hi(g.z) * sigmoid_f(a1[1]) * bf_hi(s.z);
                        o[6] = bf_lo(g.w) * sigmoid_f(a1[2]) * bf_lo(s.w); o[7] = bf_hi(g.w) * sigmoid_f(a1[3]) * bf_hi(s.w);
                        w[bj].x = cvt_pk_bf16(o[0], o[1]); w[bj].y = cvt_pk_bf16(o[2], o[3]); w[bj].z = cvt_pk_bf16(o[4], o[5]); w[bj].w = cvt_pk_bf16(o[6], o[7]);
                    }
                    stage_store16(slab, fr, fq, w[0], w[1], YC + (size_t)(u.pm * 256 + wr * 64 + ai * 128 + m * 16) * 2048 + 1024 + cw, 2048);
                }
                asm volatile("" ::: "memory");
            }
    }
};

struct EpiOut {
    static constexpr bool PERM = true, AFTER_DRAIN = false, NC = true;
    const float* xp; const float* xs; bf16_t* XB; u64* ssq_next; float* xf; LAS unsigned char* lds;
    __device__ __forceinline__ float sq8(const f32x4& y0, const f32x4& y1) const { return (y0[0] * y0[0] + y0[1] * y0[1]) + (y0[2] * y0[2] + y0[3] * y0[3]) + (y1[0] * y1[0] + y1[1] * y1[1]) + (y1[2] * y1[2] + y1[3] * y1[3]); }
    __device__ __forceinline__ void operator()(const AccT& acc, const Unit& u, int wr, int wc, int fr, int fq) const {
        const int rowb = u.pm * 256 + wr * 64 + fr, cw = u.pn * 256 + 64 * wc;
        LAS unsigned char* slab = lds + SLAB_OFF + (wr * 4 + wc) * SLAB_BYTES;
        float q[8];
#pragma unroll
        for (int i = 0; i < 8; ++i) q[i] = 0.f;
#pragma unroll
        for (int ai = 0; ai < 2; ++ai)
#pragma unroll
            for (int mp = 0; mp < 2; ++mp) {
                f32x4 x0[2][2], x1[2][2];
                if (xp) {
#pragma unroll
                    for (int mm = 0; mm < 2; ++mm)
#pragma unroll
                        for (int bj = 0; bj < 2; ++bj) { const int r = rowb + ai * 128 + (2 * mp + mm) * 16;
                            const float* b = (r < TPROMPT ? xp + (size_t)r * 1024 : xs + (size_t)(r - TPROMPT) * 1024) + cw + 32 * bj + 8 * fq; x0[mm][bj] = *(const f32x4*)b; x1[mm][bj] = *(const f32x4*)(b + 4); }
                } else {
                    u32x4 raw[2][2];
#pragma unroll
                    for (int mm = 0; mm < 2; ++mm)
#pragma unroll
                        for (int bj = 0; bj < 2; ++bj) raw[mm][bj] = *(const u32x4*)(XB + (size_t)(rowb + ai * 128 + (2 * mp + mm) * 16) * 1024 + cw + 32 * bj + 8 * fq);
#pragma unroll
                    for (int mm = 0; mm < 2; ++mm)
#pragma unroll
                        for (int bj = 0; bj < 2; ++bj) { const u32x4 w = raw[mm][bj];
                            x0[mm][bj] = (f32x4){bf_lo(w.x), bf_hi(w.x), bf_lo(w.y), bf_hi(w.y)}; x1[mm][bj] = (f32x4){bf_lo(w.z), bf_hi(w.z), bf_lo(w.w), bf_hi(w.w)}; }
                }
                asm volatile("" ::: "memory");
#pragma unroll
                for (int mm = 0; mm < 2; ++mm) { const int m = 2 * mp + mm;
                    const f32x4 y00 = x0[mm][0] + acc[ai][0][m][0], y01 = x1[mm][0] + acc[ai][0][m][1], y10 = x0[mm][1] + acc[ai][1][m][0], y11 = x1[mm][1] + acc[ai][1][m][1];
                    q[ai * 4 + m] = sq8(y00, y01) + sq8(y10, y11);
                    if (xf) { float* d = xf + (size_t)(rowb + ai * 128 + m * 16) * 1024 + cw + 8 * fq; *(f32x4*)d = y00; *(f32x4*)(d + 4) = y01; *(f32x4*)(d + 32) = y10; *(f32x4*)(d + 36) = y11; }
                    else { u32x4 w0, w1; w0.x = cvt_pk_bf16(y00[0], y00[1]); w0.y = cvt_pk_bf16(y00[2], y00[3]); w0.z = cvt_pk_bf16(y01[0], y01[1]); w0.w = cvt_pk_bf16(y01[2], y01[3]);
                        w1.x = cvt_pk_bf16(y10[0], y10[1]); w1.y = cvt_pk_bf16(y10[2], y10[3]); w1.z = cvt_pk_bf16(y11[0], y11[1]); w1.w = cvt_pk_bf16(y11[2], y11[3]);
                        stage_store16(slab, fr, fq, w0, w1, XB + (size_t)(u.pm * 256 + wr * 64 + ai * 128 + m * 16) * 1024 + cw, 1024); }
                }
                asm volatile("" ::: "memory");
            }
#pragma unroll
        for (int i = 0; i < 8; ++i) { const int r = rowb + (i >> 2) * 128 + (i & 3) * 16;
            float t = q[i]; t += __shfl_xor(t, 16); t += __shfl_xor(t, 32);
            if (fq == 0) atomicAdd(ssq_next + r, to_fx(t, FX_SSQ)); }
    }
};

struct Params { const float* in[20]; float* out; unsigned char* ws; int lo, hi; };
enum { I_XP = 0, I_XS, I_NORMG, I_WIN, I_LNG, I_LNB, I_WS, I_BS, I_LAMRE, I_LAMIM, I_LOGDT, I_BRE, I_BIM, I_CRE, I_CIM, I_DSKIP, I_WGLU, I_BGLU, I_WOUT, I_FINALG };

__device__ __forceinline__ void transpose_item(const float* W, int N, int k0, int n0, const float* scale, bf16_t* dst, int Kdst, LAS float* scr, int lane) {
    float tv[32];
#pragma unroll
    for (int i = 0; i < 32; ++i) tv[i] = W[(size_t)(k0 + 2 * i + (lane >> 5)) * N + n0 + (lane & 31)];
    if (scale) {
#pragma unroll
        for (int i = 0; i < 32; ++i) tv[i] *= scale[k0 + 2 * i + (lane >> 5)]; }
#pragma unroll
    for (int i = 0; i < 32; ++i) scr[(2 * i + (lane >> 5)) * 33 + (lane & 31)] = tv[i];
    asm volatile("s_waitcnt lgkmcnt(0)" ::: "memory");
    const int c = lane & 7;
#pragma unroll
    for (int j = 0; j < 4; ++j) { const int n = (lane >> 3) + 8 * j; const LAS float* s = scr + (8 * c) * 33 + n;
        u32x4 o; o.x = cvt_pk_bf16(s[0 * 33], s[1 * 33]); o.y = cvt_pk_bf16(s[2 * 33], s[3 * 33]); o.z = cvt_pk_bf16(s[4 * 33], s[5 * 33]); o.w = cvt_pk_bf16(s[6 * 33], s[7 * 33]);
        *(u32x4*)(dst + (size_t)n * Kdst + k0 + 8 * c) = o; }
    asm volatile("s_waitcnt lgkmcnt(0)" ::: "memory");
}

__device__ __forceinline__ void pre_phase(const Params& P, LAS unsigned char* lds, int tid, int lane, int wave) {
    unsigned char* ws = P.ws;
    {
        LAS float* scr = (LAS float*)(lds + wave * 8448);
        const int gw = blockIdx.x * 8 + wave, NGW = gridDim.x * 8;
        for (int it = gw; it < DEPTH * 4096; it += NGW) {
            const int l = it >> 12; int r = it & 4095;
            if (r < 2560) {
                const int kb = r / 160, nb = r % 160, sg = nb >> 5, b = nb & 31;
                int row;
                if (sg == 0) row = 256 * (b >> 2) + 64 * (b & 3);
                else if (sg == 1) row = 4096 + 32 * b;
                else if (sg == 2) row = 256 * (b >> 2) + 64 * (b & 3) + 32;
                else if (sg == 3) row = 2048 + 32 * b;
                else row = 3072 + 32 * b;
                transpose_item(P.in[I_WIN] + (size_t)l * 1024 * NIN, NIN, 64 * kb, 32 * nb, P.in[I_NORMG] + l * 1024,
                               (bf16_t*)(ws + WS_WIN) + ((size_t)l * NIN + row) * 1024, 1024, scr, lane);
            } else if (r < 3072) {
                r -= 2560; const int kb = r >> 5, nb = r & 31;
                transpose_item(P.in[I_WGLU] + (size_t)l * 1024 * 1024, 1024, 64 * kb, 32 * nb, nullptr,
                               (bf16_t*)(ws + WS_WGLU) + ((size_t)l * 1024 + 32 * nb) * 1024, 1024, scr, lane);
            } else {
                r -= 3072; const int kb = r >> 5, nb = r & 31;
                transpose_item(P.in[I_WOUT] + (size_t)l * 2048 * 1024, 1024, 64 * kb, 32 * nb, nullptr,
                               (bf16_t*)(ws + WS_WOUT) + ((size_t)l * 1024 + 32 * nb) * 2048, 2048, scr, lane);
            }
        }
    }
    {
        const float* src = P.in[I_WS]; bf16_t* dst = (bf16_t*)(ws + WS_WSB);
        for (int i = (blockIdx.x * NTHR + tid) * 8; i < DEPTH * 4 * 128 * 128; i += gridDim.x * NTHR * 8) {
            const f32x4 a = *(const f32x4*)(src + i), b = *(const f32x4*)(src + i + 4);
            u32x4 w; w.x = cvt_pk_bf16(a[0], a[1]); w.y = cvt_pk_bf16(a[2], a[3]); w.z = cvt_pk_bf16(b[0], b[1]); w.w = cvt_pk_bf16(b[2], b[3]);
            *(u32x4*)(dst + i) = w;
        }
    }
    {
        float* vec = (float*)(ws + WS_VEC);
        for (int i = blockIdx.x * NTHR + tid; i < VEC_N; i += gridDim.x * NTHR) {
            float v;
            if (i < VEC_LNB) v = P.in[I_LNG][i]; else if (i < VEC_BGLU) v = P.in[I_LNB][i - VEC_LNB]; else if (i < VEC_BS) v = P.in[I_BGLU][i - VEC_BGLU];
            else if (i < VEC_FG) v = P.in[I_BS][i - VEC_BS]; else v = P.in[I_FINALG][i - VEC_FG];
            vec[i] = v;
        }
    }
    __syncthreads();
    LAS f32x2* PW = (LAS f32x2*)lds;
    LAS f32x2* BB = (LAS f32x2*)(lds + 33792);
    LAS f32x2* CT = (LAS f32x2*)(lds + 33792 + 16384);
    LAS float* KT = (LAS float*)(lds + 33792 + 32768);
    LAS f32x2* FF = (LAS f32x2*)(lds + 33792 + 32768 + 65536);
    LAS float* DS = (LAS float*)(lds + 33792 + 32768 + 65536 + 1024);
    for (int lg = blockIdx.x; lg < DEPTH * 64; lg += gridDim.x) {
        const int l = lg >> 6, g = lg & 63;
        for (int it = tid; it < 2 * 33 * 64; it += NTHR) {
            const int p = it & 63, k = (it >> 6) % 33, dir = it / (33 * 64);
            const int ig = (l * 2 + dir) * 64 + g;
            const double dt = exp((double)P.in[I_LOGDT][ig]);
            const double lr = (double)P.in[I_LAMRE][ig * 64 + p] * dt, li = (double)P.in[I_LAMIM][ig * 64 + p] * dt;
            const double mag = exp(lr * (double)k); double sn, cs; sincos(li * (double)k, &sn, &cs);
            PW[(dir * 33 + k) * 64 + p] = (f32x2){(float)(mag * cs), (float)(mag * sn)};
            if (k == 1) {
                const double lre = (double)P.in[I_LAMRE][ig * 64 + p], lim = (double)P.in[I_LAMIM][ig * 64 + p];
                const double nr = mag * cs - 1.0, ni = mag * sn, den = lre * lre + lim * lim;
                FF[dir * 64 + p] = (f32x2){(float)((nr * lre + ni * lim) / den), (float)((ni * lre - nr * lim) / den)};
            }
        }
        for (int it = tid; it < 2 * 64 * 16; it += NTHR) {
            const int ch = it & 15, p = (it >> 4) & 63, dir = it >> 10;
            const size_t ci = ((size_t)((l * 2 + dir) * 64 + g) * 16 + ch) * 64 + p;
            CT[(dir * 64 + p) * 16 + ch] = (f32x2){P.in[I_CRE][ci], P.in[I_CIM][ci]};
        }
        if (tid < 16) DS[tid] = P.in[I_DSKIP][l * 1024 + g * 16 + tid];
        __syncthreads();
        for (int it = tid; it < 2 * 64 * 16; it += NTHR) {
            const int c = it & 15, p = (it >> 4) & 63, dir = it >> 10;
            const size_t bi = ((size_t)((l * 2 + dir) * 64 + g) * 64 + p) * 16 + c;
            const float br = P.in[I_BRE][bi], bm = P.in[I_BIM][bi]; const f32x2 f = FF[dir * 64 + p];
            BB[(dir * 64 + p) * 16 + c] = (f32x2){f.x * br - f.y * bm, f.x * bm + f.y * br};
        }
        __syncthreads();
        for (int it = tid; it < 2 * 32 * 64; it += NTHR) {
            const int ch = it & 15, cq = (it >> 4) & 3, lag = (it >> 6) & 31, dir = it >> 11;
            float a0 = 0.f, a1 = 0.f, a2 = 0.f, a3 = 0.f;
            for (int p = 0; p < 64; ++p) {
                const f32x2 c = CT[(dir * 64 + p) * 16 + ch], w = PW[(dir * 33 + lag) * 64 + p];
                const float xr = c.x * w.x - c.y * w.y, xi = c.x * w.y + c.y * w.x;
                const LAS f32x2* bp = BB + (dir * 64 + p) * 16 + cq * 4;
                a0 += xr * bp[0].x - xi * bp[0].y; a1 += xr * bp[1].x - xi * bp[1].y; a2 += xr * bp[2].x - xi * bp[2].y; a3 += xr * bp[3].x - xi * bp[3].y;
            }
            LAS float* kp = KT + ((dir * 32 + lag) * 16 + ch) * 16 + cq * 4; kp[0] = a0; kp[1] = a1; kp[2] = a2; kp[3] = a3;
        }
        __syncthreads();
        {
            bf16_t* W3 = (bf16_t*)(ws + WS_W3) + (size_t)lg * 512 * XSK;
            for (int it = tid; it < 512 * 96; it += NTHR) {
                const int kc = it % 96, n = it / 96, t = n >> 4, ch = n & 15, k0 = kc * 8;
                float v[8];
                if (k0 < 512) {
                    const int s = k0 >> 4, c0 = k0 & 15;
#pragma unroll
                    for (int j = 0; j < 8; ++j) {
                        float x = 0.f;
                        if (s <= t) x += KT[((0 * 32 + (t - s)) * 16 + ch) * 16 + c0 + j];
                        if (s >= t) x += KT[((1 * 32 + (s - t)) * 16 + ch) * 16 + c0 + j];
                        if (s == t && ch == c0 + j) x += DS[ch];
                        v[j] = x;
                    }
                } else {
                    const int q = k0 - 512, dir = q >> 7, p0 = (q & 127) >> 1, e = dir == 0 ? t + 1 : QC - t;
#pragma unroll
                    for (int j = 0; j < 8; ++j) {
                        const f32x2 c = CT[(dir * 64 + p0 + (j >> 1)) * 16 + ch], w = PW[(dir * 33 + e) * 64 + p0 + (j >> 1)];
                        v[j] = (j & 1) == 0 ? (c.x * w.x - c.y * w.y) : -(c.x * w.y + c.y * w.x);
                    }
                }
                u32x4 o; o.x = cvt_pk_bf16(v[0], v[1]); o.y = cvt_pk_bf16(v[2], v[3]); o.z = cvt_pk_bf16(v[4], v[5]); o.w = cvt_pk_bf16(v[6], v[7]);
                *(u32x4*)(W3 + (size_t)n * XSK + k0) = o;
            }
        }
        {
            bf16_t* W1 = (bf16_t*)(ws + WS_W1) + (size_t)lg * 256 * 512;
            for (int it = tid; it < 256 * 64; it += NTHR) {
                const int kc = it & 63, n = it >> 6, k0 = kc * 8, s = k0 >> 4, c0 = k0 & 15, dir = n >> 7, ri = (n >> 6) & 1, p = n & 63, e = dir == 0 ? (QC - 1 - s) : s;
                const f32x2 w = PW[(dir * 33 + e) * 64 + p];
                float v[8];
#pragma unroll
                for (int j = 0; j < 8; ++j) { const f32x2 b = BB[(dir * 64 + p) * 16 + c0 + j]; v[j] = ri == 0 ? (w.x * b.x - w.y * b.y) : (w.x * b.y + w.y * b.x); }
                u32x4 o; o.x = cvt_pk_bf16(v[0], v[1]); o.y = cvt_pk_bf16(v[2], v[3]); o.z = cvt_pk_bf16(v[4], v[5]); o.w = cvt_pk_bf16(v[6], v[7]);
                *(u32x4*)(W1 + (size_t)n * 512 + k0) = o;
            }
        }
        if (tid < 128) { const int dir = tid >> 6, p = tid & 63; const f32x2 w = PW[(dir * 33 + QC) * 64 + p];
            float* aq = (float*)(ws + WS_AQ) + ((size_t)(lg * 2 + dir) * 64 + p) * 2; aq[0] = w.x; aq[1] = w.y; }
        __syncthreads();
    }
}

__device__ __forceinline__ void p0_phase(const Params& P, int wv) {
    const int tid = opaque_tid(wv), lane = tid & 63, wave = __builtin_amdgcn_readfirstlane(tid >> 6), bid = opaque_bid();
    bf16_t* XB = (bf16_t*)(P.ws + WS_XB); u64* ssq = (u64*)(P.ws + WS_SSQ);
    for (int r = bid * 8 + wave; r < TP; r += gridDim.x * 8) {
        const float* src = r < TPROMPT ? P.in[I_XP] + (size_t)r * 1024 : P.in[I_XS] + (size_t)(r - TPROMPT) * 1024;
        const f32x4* xr = (const f32x4*)src + lane; u32x2* o = (u32x2*)(XB + (size_t)r * 1024) + lane;
        float s = 0.f;
#pragma unroll
        for (int j = 0; j < 4; ++j) { const f32x4 v = xr[64 * j]; s += (v[0] * v[0] + v[1] * v[1]) + (v[2] * v[2] + v[3] * v[3]); o[64 * j] = (u32x2){cvt_pk_bf16(v[0], v[1]), cvt_pk_bf16(v[2], v[3])}; }
        s = wave_sum(s);
        if (lane == 0) ssq[r] = to_fx(s, FX_SSQ);
    }
}
__device__ __forceinline__ void pz_phase(const Params& P, int wv) {
    const int tid = opaque_tid(wv), lane = tid & 63, wave = __builtin_amdgcn_readfirstlane(tid >> 6), bid = opaque_bid();
    const float* XF = (const float*)(P.ws + WS_XF); const u64* ssq = (const u64*)(P.ws + WS_SSQ) + (size_t)DEPTH * TP;
    const f32x4* fg = (const f32x4*)((const float*)(P.ws + WS_VEC) + VEC_FG) + lane;
    for (int r = bid * 8 + wave; r < TP; r += gridDim.x * 8) {
        const f32x4* xr = (const f32x4*)(XF + (size_t)r * 1024) + lane; f32x4* o = (f32x4*)(P.out + (size_t)r * 1024) + lane;
        const float rstd = rstd_of(ssq[r]);
#pragma unroll
        for (int j = 0; j < 4; ++j) o[64 * j] = xr[64 * j] * rstd * fg[64 * j];
    }
}

__device__ __forceinline__ void spatial_phase(unsigned char* ws, bf16_t* YC, LAS unsigned char* lds, int layer, bf16_t* dry, int wv) {
    const int tid = opaque_tid(wv);
    const int wave = __builtin_amdgcn_readfirstlane(tid >> 6), lane = tid & 63, fr = lane & 15, fq = lane >> 4;
    const int c = opaque_bid(), h = c & 3, wj = wave >> 1, wp = wave & 1;
    const bf16_t* GV = (const bf16_t*)(ws + WS_GV);
    const u64* vsum = (const u64*)(ws + WS_VSUM) + (size_t)layer * TP;
    const u64* vsq = (const u64*)(ws + WS_VSQ) + (size_t)layer * TP;
    const float* vec = (const float*)(ws + WS_VEC);
    const float* lng = vec + VEC_LNG + layer * 1024; const float* lnb = vec + VEC_LNB + layer * 1024; const float* bs = vec + VEC_BS + (layer * 4 + h) * 128;
    LAS unsigned char* WsL = lds; LAS unsigned char* GvL = lds + 34816;
    const int ch = tid & 15, r0 = tid >> 4;
    {
        const bf16_t* src = (const bf16_t*)(ws + WS_WSB) + (size_t)(layer * 4 + h) * 128 * 128;
#pragma unroll
        for (int i = 0; i < 4; ++i) { const int r = r0 + 32 * i; *(LAS u32x4*)(WsL + r * 272 + ch * 16) = *(const u32x4*)(src + r * 128 + ch * 8); }
    }
    float lg[8], lb[8];
#pragma unroll
    for (int ii = 0; ii < 8; ++ii) { lg[ii] = lng[256 * h + r0 + 32 * ii]; lb[ii] = lnb[256 * h + r0 + 32 * ii]; }
    float bsv[4];
#pragma unroll
    for (int pt = 0; pt < 4; ++pt) bsv[pt] = bs[64 * wp + 16 * pt + fr];
    const int cstride = (int)(gridDim.x >> 2), nchunks = TP / 128;
    LAS f32x2* ST = (LAS f32x2*)(lds + 34816 + 69632);
    for (int i = tid; i < ((nchunks - (c >> 2) + cstride - 1) / cstride) * 128; i += NTHR) {
        const int t = ((c >> 2) + (i >> 7) * cstride) * 128 + (i & 127);
        const float m = from_fx(vsum[t], (1.0f / FX_V) * (1.0f / 1024.0f)), q = from_fx(vsq[t], (1.0f / FX_V) * (1.0f / 1024.0f));
        ST[i] = (f32x2){m, rsqrtf(fmaxf(q - m * m, 0.f) + EPS)};
    }
    u32x4 raw[8];
#define SP_LOAD(CI) do { const int _t0 = (CI) * 128; _Pragma("unroll") for (int ii = 0; ii < 8; ++ii) raw[ii] = *(const u32x4*)(GV + (size_t)(256 * h + r0 + 32 * ii) * TP + _t0 + ch * 8); } while (0)
    int cidx = c >> 2, ui = 0;
    if (cidx < nchunks) SP_LOAD(cidx);
    for (; cidx < nchunks; cidx += cstride, ++ui) {
        const int t0 = cidx * 128;
        __syncthreads();
        float mu[8], rs[8];
#pragma unroll
        for (int k = 0; k < 8; ++k) { const f32x2 s = ST[ui * 128 + ch * 8 + k]; mu[k] = s.x; rs[k] = s.y; }
#pragma unroll
        for (int ii = 0; ii < 8; ++ii) {
            const int j = r0 + 32 * ii; const u32x4 w0 = raw[ii]; const float g = lg[ii], b = lb[ii];
            float y[8];
            y[0] = (bf_lo(w0.x) - mu[0]) * rs[0] * g + b; y[1] = (bf_hi(w0.x) - mu[1]) * rs[1] * g + b;
            y[2] = (bf_lo(w0.y) - mu[2]) * rs[2] * g + b; y[3] = (bf_hi(w0.y) - mu[3]) * rs[3] * g + b;
            y[4] = (bf_lo(w0.z) - mu[4]) * rs[4] * g + b; y[5] = (bf_hi(w0.z) - mu[5]) * rs[5] * g + b;
            y[6] = (bf_lo(w0.w) - mu[6]) * rs[6] * g + b; y[7] = (bf_hi(w0.w) - mu[7]) * rs[7] * g + b;
            u32x4 w; w.x = cvt_pk_bf16(y[0], y[1]); w.y = cvt_pk_bf16(y[2], y[3]); w.z = cvt_pk_bf16(y[4], y[5]); w.w = cvt_pk_bf16(y[6], y[7]);
            *(LAS u32x4*)(GvL + j * 272 + ch * 16) = w;
        }
        __syncthreads();
        if (cidx + cstride < nchunks) SP_LOAD(cidx + cstride);
        u32x4 p1[4][2];
#pragma unroll
        for (int pt = 0; pt < 4; ++pt)
#pragma unroll
            for (int u2 = 0; u2 < 2; ++u2) p1[pt][u2] = *(const u32x4*)(YC + (size_t)(t0 + 64 * wp + 16 * pt + fr) * 2048 + 256 * h + 64 * wj + 32 * u2 + 8 * fq);
        asm volatile("" ::: "memory");
        f32x4 acc[2][2][4];
#pragma unroll
        for (int a = 0; a < 2; ++a)
#pragma unroll
            for (int n = 0; n < 2; ++n)
#pragma unroll
                for (int pt = 0; pt < 4; ++pt) acc[a][n][pt] = (f32x4){0.f, 0.f, 0.f, 0.f};
#pragma unroll
        for (int ks = 0; ks < 4; ++ks) {
            bf16x8 av[2][2], bv[4];
#pragma unroll
            for (int u2 = 0; u2 < 2; ++u2)
#pragma unroll
                for (int n = 0; n < 2; ++n) { const int j = 64 * wj + 32 * u2 + 8 * (fr >> 2) + 4 * n + (fr & 3); av[u2][n] = *(const LAS bf16x8*)(GvL + j * 272 + ks * 64 + fq * 16); }
#pragma unroll
            for (int pt = 0; pt < 4; ++pt) { const int p = 64 * wp + 16 * pt + fr; bv[pt] = *(const LAS bf16x8*)(WsL + p * 272 + ks * 64 + fq * 16); }
#pragma unroll
            for (int u2 = 0; u2 < 2; ++u2)
#pragma unroll
                for (int n = 0; n < 2; ++n)
#pragma unroll
                    for (int pt = 0; pt < 4; ++pt) acc[u2][n][pt] = __builtin_amdgcn_mfma_f32_16x16x32_bf16(av[u2][n], bv[pt], acc[u2][n][pt], 0, 0, 0);
        }
#pragma unroll
        for (int pt = 0; pt < 4; ++pt) {
#pragma unroll
            for (int u2 = 0; u2 < 2; ++u2) {
                bf16_t* yp = YC + (size_t)(t0 + 64 * wp + 16 * pt + fr) * 2048 + 256 * h + 64 * wj + 32 * u2 + 8 * fq;
                const u32x4 pv = p1[pt][u2];
                const f32x4 d0 = acc[u2][0][pt] + bsv[pt], d1 = acc[u2][1][pt] + bsv[pt];
                u32x4 w;
                w.x = cvt_pk_bf16(bf_lo(pv.x) * d0[0], bf_hi(pv.x) * d0[1]); w.y = cvt_pk_bf16(bf_lo(pv.y) * d0[2], bf_hi(pv.y) * d0[3]);
                w.z = cvt_pk_bf16(bf_lo(pv.z) * d1[0], bf_hi(pv.z) * d1[1]); w.w = cvt_pk_bf16(bf_lo(pv.w) * d1[2], bf_hi(pv.w) * d1[3]);
                *(u32x4*)(dry ? dry + lane_id() * 8 : yp) = w;
            }
        }
        asm volatile("" ::: "memory");
    }
#undef SP_LOAD
    __syncthreads();
}

__global__ void __launch_bounds__(NTHR, 2) mk_fwd(Params P) {
    extern __shared__ __attribute__((aligned(16))) unsigned char lds_raw[];
    LAS unsigned char* lds = (LAS unsigned char*)lds_raw;
    volatile LAS unsigned* MISC = (volatile LAS unsigned*)(lds + MISC_OFF);
    const int tid = threadIdx.x, lane = tid & 63, wave = __builtin_amdgcn_readfirstlane(tid >> 6);
    if (tid < 64) MISC[tid] = 0u;
    __syncthreads();
    unsigned char* ws = P.ws;
    XcdBarrier bar; bar.bar = (unsigned*)(ws + WS_BAR); bar.x = 0; bar.st = MISC + 8;
    if (P.hi - P.lo > 1) bar = xcd_barrier_post((unsigned*)(ws + WS_BAR), MISC + 8);
    bar.wv = wave;
#define RUN(s) (P.lo <= (s) && (s) < P.hi)
#define SEAM(s) do { if (RUN(s) && RUN((s) + 1)) { xcd_barrier(bar); if (DUP == 12) xcd_barrier(bar); } } while (0)
    int step = 0;
    bf16_t* YC = (bf16_t*)P.out;
    if (RUN(step)) { for (int rr = 0; rr < (DUP == 9 ? 2 : 1); ++rr) { const int t2 = opaque_tid(wave); pre_phase(P, lds, t2, t2 & 63, wave); __syncthreads(); } p0_phase(P, wave); if (DUP == 10) p0_phase(P, wave); }
    SEAM(step); ++step;
    for (int layer = 0; layer < DEPTH; ++layer) {
        const u64* ssq = (const u64*)(ws + WS_SSQ) + (size_t)layer * TP;
        if (RUN(step)) for (int rr = 0; rr < ((DUP == 1 || DUP == 2) ? 2 : 1); ++rr) {
            if (rr == 0 || DUP == 1) {
                pg8::GOp A{(const char*)(ws + WS_XB), 2048u, 32u, 128, 0};
                pg8::GOp B{(const char*)(ws + WS_WIN) + (size_t)layer * NIN * 1024 * 2, 2048u, 32u, 128, 0};
                pg8::SchedStd S; S.init(TP, 4096, gridDim.x, opaque_bid(), PA_WGM);
                EpiInMain E{YC, (bf16_t*)(ws + WS_XS), ssq, lds};
                pg8::gemm_phase(lds, A, B, 16, S, E, wave);
            }
            if (DUP == 21 && rr == 0) {
                pg8::GOp A{(const char*)(ws + WS_XB), 2048u, 32u, 128, 0};
                pg8::GOp B{(const char*)(ws + WS_WIN) + (size_t)layer * NIN * 1024 * 2, 2048u, 32u, 128, 0};
                pg8::SchedWrap S; S.init(TP, 4096, gridDim.x, opaque_bid());
                EpiNull E{};
                pg8::gemm_phase(lds, A, B, 16, S, E, wave);
            }
            if (DUP == 11 && rr == 0) {
                pg8::GOp A{(const char*)(ws + WS_XB), 2048u, 32u, 128, 0};
                pg8::GOp B{(const char*)(ws + WS_WIN) + (size_t)layer * NIN * 1024 * 2, 2048u, 32u, 128, 0};
                pg8::SchedStd S; S.init(TP, 4096, gridDim.x, opaque_bid());
                EpiNull E{};
                pg8::gemm_phase(lds, A, B, 16, S, E, wave);
            }
            if (DUP == 15 && rr == 0) {
                pg8::GOp A{(const char*)(ws + WS_WIN) + ((size_t)layer * NIN + 4096) * 1024 * 2, 2048u, 32u, 128, 0};
                pg8::GOp B{(const char*)(ws + WS_XB), 2048u, 32u, 128, 0};
                pg8::SchedStd S; S.init(1024, TP, gridDim.x, opaque_bid());
                EpiNull E{};
                pg8::gemm_phase(lds, A, B, 16, S, E, wave);
            }
            if (rr == 0 || DUP == 2) {
                pg8::GOp A{(const char*)(ws + WS_WIN) + ((size_t)layer * NIN + 4096) * 1024 * 2, 2048u, 32u, 128, 0};
                pg8::GOp B{(const char*)(ws + WS_XB), 2048u, 32u, 128, 0};
                pg8::SchedStd S; S.init(1024, TP, gridDim.x, opaque_bid());
                EpiInV E{(bf16_t*)(ws + WS_GV), ssq, rr ? (u64*)(ws + WS_DUMMY + 1 * MiB) : (u64*)(ws + WS_VSUM) + (size_t)layer * TP, rr ? (u64*)(ws + WS_DUMMY + 2 * MiB) : (u64*)(ws + WS_VSQ) + (size_t)layer * TP, lds};
                pg8::gemm_phase(lds, A, B, 16, S, E, wave);
            }
        }
        SEAM(step); ++step;
        if (RUN(step)) {
            for (int rr = 0; rr < (DUP == 3 ? 2 : 1); ++rr)
            for (int rep = 0; rep < (64 * (NCH / 256)) / GRID; ++rep) {
                pg8::GOp A{(const char*)(ws + WS_XS), (unsigned)(XSK * 2), 32u, 128, (size_t)NCH * XSK * 2};
                pg8::GOp B{(const char*)(ws + WS_W1) + (size_t)layer * 64 * 256 * 512 * 2, 1024u, 32u, 128, (size_t)256 * 512 * 2};
                const int L = rep * GRID + opaque_bid(), nwg = 64 * (NCH / 256), w = (L % 8) * (nwg / 8) + L / 8;
                pg8::SchedOne S; S.u.g = w / (NCH / 256); S.u.pm = w % (NCH / 256); S.u.pn = 0;
                EpiS1Scan E{(bf16_t*)(ws + WS_XS), (const float*)(ws + WS_AQ) + (size_t)layer * 64 * 2 * 64 * 2};
                pg8::gemm_phase(lds, A, B, 8, S, E, wave);
            }
            if (DUP == 4) spatial_phase(ws, YC, lds, layer, (bf16_t*)(ws + WS_DUMMY), wave);
            spatial_phase(ws, YC, lds, layer, nullptr, wave);
        }
        SEAM(step); ++step;
        if (RUN(step)) for (int rr = 0; rr < (DUP == 6 ? 2 : 1); ++rr) {
            pg8::GOp A{(const char*)(ws + WS_XS), (unsigned)(XSK * 2), 32u, 128, (size_t)NCH * XSK * 2};
            pg8::GOp B{(const char*)(ws + WS_W3) + (size_t)layer * 64 * 512 * XSK * 2, (unsigned)(XSK * 2), 32u, 128, (size_t)512 * XSK * 2};
            pg8::SchedBatch S; S.init(64, NCH / 256, 2, gridDim.x, opaque_bid());
            if (DUP == 13 && rr == 0) { EpiNull E0{}; pg8::gemm_phase(lds, A, B, 12, S, E0, wave); }
            EpiBf16<1> E{(bf16_t*)(ws + WS_GV), 512, (size_t)NCH * 512, lds};
            pg8::gemm_phase(lds, A, B, 12, S, E, wave);
        }
        SEAM(step); ++step;
        if (RUN(step)) for (int rr = 0; rr < 1; ++rr) {
            pg8::GOp A{(const char*)(ws + WS_GV), 32u, (unsigned)(TP * 32), (size_t)4 * TP * 32, 0};
            pg8::GOp B{(const char*)(ws + WS_WGLU) + (size_t)layer * 1024 * 1024 * 2, 2048u, 32u, 128, 0};
            pg8::SchedStd S; S.init(TP, 1024, gridDim.x, opaque_bid());
            if (DUP == 14 && rr == 0) { EpiNull E0{}; pg8::gemm_phase(lds, A, B, 16, S, E0, wave); }
            EpiGlu E{(const bf16_t*)(ws + WS_GV), YC, (const float*)(ws + WS_VEC) + VEC_BGLU + layer * 1024, lds};
            pg8::gemm_phase(lds, A, B, 16, S, E, wave);
        }
        SEAM(step); ++step;
        if (RUN(step)) for (int rr = 0; rr < 1; ++rr) {
            pg8::GOp A{(const char*)YC, 4096u, 32u, 128, 0};
            pg8::GOp B{(const char*)(ws + WS_WOUT) + (size_t)layer * 1024 * 2048 * 2, 4096u, 32u, 128, 0};
            pg8::SchedStd S; S.init(TP, 1024, gridDim.x, opaque_bid());
            if (DUP == 16 && rr == 0) { EpiNull E0{}; pg8::gemm_phase(lds, A, B, 32, S, E0, wave); }
            EpiOut E{layer == 0 ? P.in[I_XP] : nullptr, P.in[I_XS], (bf16_t*)(ws + WS_XB), (u64*)(ws + WS_SSQ) + (size_t)(layer + 1) * TP, layer == DEPTH - 1 ? (float*)(ws + WS_XF) : nullptr, lds};
            pg8::gemm_phase(lds, A, B, 32, S, E, wave);
        }
        SEAM(step); ++step;
    }
    if (RUN(step)) pz_phase(P, wave);
    ++step;
#undef RUN
#undef SEAM
}

extern "C" void kernel_launch(void* const* d_in, const int* in_sizes, int n_in, void* d_out, int out_size, void* d_ws, size_t ws_size, hipStream_t stream) {
    static int ready = 0;
    if (ready == 0) {
        if (n_in != 20 || out_size != TALL * D || ws_size < WS_END) { fprintf(stderr, "kernel_launch: unexpected shapes (n_in %d, out %d, ws %zu)\n", n_in, out_size, ws_size); ready = -1; return; }
        if (hipFuncSetAttribute((const void*)mk_fwd, hipFuncAttributeMaxDynamicSharedMemorySize, LDS_BYTES) != hipSuccess) { fprintf(stderr, "kernel_launch: hipFuncSetAttribute failed\n"); ready = -1; return; }
        ready = 1;
    }
    if (ready < 0) return;
    (void)hipMemsetAsync(d_ws, 0, ZERO_BYTES, stream);
    Params p{};
    for (int i = 0; i < 20; ++i) p.in[i] = (const float*)d_in[i];
    p.out = (float*)d_out; p.ws = (unsigned char*)d_ws;
#if MK_ONE_LAUNCH
    p.lo = 0; p.hi = NSTEPS;
    hipLaunchKernelGGL(mk_fwd, dim3(GRID), dim3(NTHR), LDS_BYTES, stream, p);
#else
    for (int s = 0; s < NSTEPS; ++s) { p.lo = s; p.hi = s + 1; hipLaunchKernelGGL(mk_fwd, dim3(GRID), dim3(NTHR), LDS_BYTES, stream, p); }
#endif
}
```

```cpp
#include <hip/hip_runtime.h>
#include <cstdio>
#include <cstdint>

#ifndef DUP
#define DUP 0
#endif
#ifndef PA_WGM
#define PA_WGM 8
#endif
#ifndef PA_ROT
#define PA_ROT 0
#endif
#ifndef PA_STAGGER
#define PA_STAGGER 0
#endif
#ifndef MK_ONE_LAUNCH
#define MK_ONE_LAUNCH 1
#endif

#define LAS __attribute__((address_space(3)))
typedef unsigned short bf16_t;
typedef short bf16x8 __attribute__((ext_vector_type(8)));
typedef float f32x4 __attribute__((ext_vector_type(4)));
typedef float f32x2 __attribute__((ext_vector_type(2)));
typedef unsigned u32x4 __attribute__((ext_vector_type(4)));
typedef unsigned u32x2 __attribute__((ext_vector_type(2)));

constexpr int D = 1024, DEPTH = 4, TALL = 98304, TP = 98304  , TPROMPT = 32768, QC = 32, NCH = TP / QC  ;
constexpr int NIN = 5120, XSK = 768  ;
constexpr float EPS = 1e-6f;
constexpr int GRID = 256, NTHR = 512;
constexpr int NSTEPS = 1 + DEPTH * 5 + 1;

constexpr size_t MiB = 1u << 20, KiB = 1u << 10;
constexpr size_t WS_BAR = 0;
constexpr size_t WS_SSQ = 64 * KiB;
constexpr size_t WS_VSUM = WS_SSQ + (size_t)(DEPTH + 1) * TP * 8;
constexpr size_t WS_VSQ = WS_VSUM + (size_t)DEPTH * TP * 8;
constexpr size_t ZERO_BYTES = WS_VSQ + (size_t)DEPTH * TP * 8;
static_assert(ZERO_BYTES % 16 == 0 && ZERO_BYTES <= 11 * MiB, "zero region");
constexpr size_t WS_VEC = 11 * MiB;
constexpr int VEC_LNG = 0, VEC_LNB = 4096, VEC_BGLU = 8192, VEC_BS = 12288, VEC_FG = 14336, VEC_N = 15360;
constexpr size_t WS_AQ = 11 * MiB + 512 * KiB;
constexpr size_t WS_WSB = 12 * MiB;
constexpr size_t WS_WIN = 13 * MiB;
constexpr size_t WS_WGLU = 53 * MiB;
constexpr size_t WS_WOUT = 61 * MiB;
constexpr size_t WS_W1 = 77 * MiB;
constexpr size_t WS_W3 = 141 * MiB;
constexpr size_t WS_XB = 333 * MiB;
constexpr size_t WS_GV = 525 * MiB;
constexpr size_t WS_XS = 717 * MiB;
constexpr size_t WS_XF = WS_GV;
constexpr size_t WS_END = 1005 * MiB;
constexpr size_t WS_DUMMY = 1005 * MiB;

constexpr int LDS_BYTES = 151552;
constexpr int SLAB_OFF = 131072, SLAB_BYTES = 2304;
constexpr int MISC_OFF = LDS_BYTES - 256;

__device__ __forceinline__ unsigned cvt_pk_bf16(float lo, float hi) { unsigned r; asm volatile("v_cvt_pk_bf16_f32 %0, %1, %2" : "=v"(r) : "v"(lo), "v"(hi)); return r; }
__device__ __forceinline__ float bf_lo(unsigned w) { return __uint_as_float(w << 16); }
__device__ __forceinline__ float bf_hi(unsigned w) { return __uint_as_float(w & 0xffff0000u); }
__device__ __forceinline__ float bf2f(bf16_t b) { return __uint_as_float(((unsigned)b) << 16); }
__device__ __forceinline__ bf16_t f2bf(float f) { return (bf16_t)(cvt_pk_bf16(f, 0.f) & 0xffffu); }
__device__ __forceinline__ float fexp2(float x) { return __builtin_amdgcn_exp2f(x); }
__device__ __forceinline__ float frcp(float x) { return __builtin_amdgcn_rcpf(x); }
__device__ __forceinline__ float gelu_t(float x) {
    const float u = x * (1.0f + 0.044715f * x * x);
    return x * frcp(1.0f + fexp2(u * (-2.0f * 0.7978845608f * 1.4426950409f)));
}
__device__ __forceinline__ float sigmoid_f(float z) { return frcp(1.0f + fexp2(z * -1.4426950409f)); }
#ifndef ST_POLICY
#define ST_POLICY 0
#endif
__device__ __forceinline__ void st16(void* p, u32x4 v) {
#if ST_POLICY == 1
    __builtin_nontemporal_store(v, (u32x4*)p);
#else
    *(u32x4*)p = v;
#endif
}
__device__ __forceinline__ void stage_store16(LAS unsigned char* slab, int fr, int fq, u32x4 w0, u32x4 w1, bf16_t* row0, size_t ld) {
    *(LAS u32x4*)(slab + fr * 144 + fq * 16) = w0; *(LAS u32x4*)(slab + fr * 144 + 64 + fq * 16) = w1;
    asm volatile("s_waitcnt lgkmcnt(0)" ::: "memory");
    const int l = fq * 16 + fr;
    const u32x4 a = *(const LAS u32x4*)(slab + (l >> 3) * 144 + (l & 7) * 16), b = *(const LAS u32x4*)(slab + (8 + (l >> 3)) * 144 + (l & 7) * 16);
    asm volatile("s_waitcnt lgkmcnt(0)" ::: "memory");
    st16(row0 + (size_t)(l >> 3) * ld + (l & 7) * 8, a); st16(row0 + (size_t)(8 + (l >> 3)) * ld + (l & 7) * 8, b);
}
typedef unsigned long long u64;
constexpr float FX_SSQ = 16777216.0f  , FX_V = 4294967296.0f  ;
__device__ __forceinline__ u64 to_fx(float v, float scale) { return (u64)(long long)(v * scale); }
__device__ __forceinline__ float from_fx(u64 x, float inv_scale) { return (float)(long long)x * inv_scale; }
__device__ __forceinline__ float rstd_of(u64 ssq_fx) { return rsqrtf(from_fx(ssq_fx, (1.0f / FX_SSQ) * (1.0f / 1024.0f)) + EPS); }
__device__ __forceinline__ float wave_sum(float v) {
#pragma unroll
    for (int o = 1; o < 64; o <<= 1) v += __shfl_xor(v, o);
    return v;
}

__device__ __forceinline__ int lane_id() { int l; asm volatile("v_mbcnt_lo_u32_b32 %0, -1, 0\n\tv_mbcnt_hi_u32_b32 %0, -1, %0" : "=v"(l)); return l; }
__device__ __forceinline__ int opaque_tid(int wv) { int t = wv * 64 + lane_id(); asm volatile("" : "+v"(t)); return t; }
__device__ __forceinline__ int opaque_bid() { int b = blockIdx.x; asm volatile("" : "+s"(b)); return b; }

#define XB_TMO      128
#define XB_XCNT(j)  (256  + 64 * (j))
#define XB_XSUB(j)  (1280 + 64 * (j))
#define XB_XGEN(j)  (2304 + 64 * (j))
#define XB_TOP      3328
#define XB_TOPGEN   3392
#define XCD_BAR_WORDS 3456
#define XB_SPIN_CAP (1u << 18)
__device__ __forceinline__ unsigned xb_ld(unsigned* p)              { return __hip_atomic_load(p, __ATOMIC_RELAXED, __HIP_MEMORY_SCOPE_AGENT); }
__device__ __forceinline__ unsigned xb_add(unsigned* p, unsigned v) { return __hip_atomic_fetch_add(p, v, __ATOMIC_RELAXED, __HIP_MEMORY_SCOPE_AGENT); }
__device__ __forceinline__ unsigned xb_xcc_id() { return (unsigned)__builtin_amdgcn_s_getreg((3 << 11) | 20) & 0xFu; }
#define XB_SPIN(cond, bar) do { unsigned _sp = 0; while (cond) { __builtin_amdgcn_s_sleep(1); \
    if ((++_sp & 255u) == 0u) { if (xb_ld(&(bar)[XB_TMO])) break; if (_sp > XB_SPIN_CAP) { atomicAdd(&(bar)[XB_TMO], 1u); break; } } } } while (0)
struct XcdBarrier { unsigned* bar; unsigned x; volatile LAS unsigned* st; int wv; };
__device__ __forceinline__ XcdBarrier xcd_barrier_post(unsigned* bar, volatile LAS unsigned* st) {
    XcdBarrier b; b.bar = bar; b.x = xb_xcc_id(); b.st = st; b.wv = 0;
    if (threadIdx.x == 0) (void)xb_add(&bar[XB_XCNT(b.x)], 1u);
    return b;
}
__device__ __forceinline__ void xcd_barrier_complete(unsigned* bar, unsigned x, unsigned& nloc, unsigned& nx) {
    const unsigned G = gridDim.x * gridDim.y * gridDim.z;
    unsigned sum, cnt, mine, sp = 0u;
    for (;;) {
        sum = 0u; cnt = 0u; mine = 0u;
#pragma unroll
        for (unsigned j = 0; j < 16; ++j) { const unsigned c = xb_ld(&bar[XB_XCNT(j)]); sum += c; cnt += (c > 0u) ? 1u : 0u; mine = (j == x) ? c : mine; }
        if (sum == G) break;
        __builtin_amdgcn_s_sleep(1);
        if ((++sp & 255u) == 0u) { if (xb_ld(&bar[XB_TMO])) break; if (sp > XB_SPIN_CAP) { atomicAdd(&bar[XB_TMO], 1u); break; } }
    }
    nloc = mine > 0u ? mine : 1u; nx = cnt > 0u ? cnt : 1u;
}
__device__ __forceinline__ void xcd_barrier(const XcdBarrier& b) {
    asm volatile("s_waitcnt vmcnt(0)" ::: "memory");
    __syncthreads();
    if (b.wv == 0 && lane_id() == 0) {
        unsigned* bar = b.bar;
        __builtin_amdgcn_s_waitcnt(0);
        unsigned nloc = b.st[0], nx = b.st[1];
        if (nloc == 0u) { xcd_barrier_complete(bar, b.x, nloc, nx); b.st[0] = nloc; b.st[1] = nx; }
        const unsigned old = xb_add(&bar[XB_XSUB(b.x)], 1u);
        const unsigned gen = old / nloc;
        if (old + 1u == (gen + 1u) * nloc) {
            __builtin_amdgcn_fence(__ATOMIC_RELEASE, "agent");
            asm volatile("s_waitcnt vmcnt(0)" ::: "memory");
            const unsigned og = xb_add(&bar[XB_TOP], 1u);
            const unsigned tg = og / nx;
            if (og + 1u == (tg + 1u) * nx) xb_add(&bar[XB_TOPGEN], 1u);
            else XB_SPIN(xb_ld(&bar[XB_TOPGEN]) == tg, bar);
            __builtin_amdgcn_fence(__ATOMIC_ACQUIRE, "agent");
            xb_add(&bar[XB_XGEN(b.x)], 1u);
            asm volatile("s_waitcnt vmcnt(0)" ::: "memory");
        } else {
            XB_SPIN(xb_ld(&bar[XB_XGEN(b.x)]) == gen, bar);
            __builtin_amdgcn_fence(__ATOMIC_ACQUIRE, "agent");
            asm volatile("s_waitcnt vmcnt(0)" ::: "memory");
        }
    }
    __syncthreads();
}

namespace pg8 {
constexpr int BM = 256, BK = 64, HALF = 128, HTB = HALF * BK * 2, STAGE_BYTES = 8 * HTB, NXCD = 8, WGM = 8;
__host__ __device__ __forceinline__ int lds_byte(int r, int c) { const int st = (r >> 4) * 2 + (c >> 5), rr = r & 15, cc = c & 31, ob = rr * 64 + cc * 2; return st * 1024 + (ob ^ (((ob >> 9) & 1) << 5)); }
__host__ __device__ __forceinline__ void stage_rc(int b, int& R, int& C) { const int st = b / 1024, sb = b % 1024, swz = sb ^ (((sb >> 9) & 1) << 5); R = (st >> 1) * 16 + swz / 64; C = (st & 1) * 32 + (swz % 64) / 2; }
__host__ __device__ __forceinline__ int perm32(int rho) { const int n = rho >> 4, i = rho & 15; return 8 * (i >> 2) + 4 * n + (i & 3); }

struct Unit { int pm, pn, g; };
struct GOp { const char* base; unsigned rs, cs; size_t kstep, gstride; };

struct SchedStd {
    int nM, nN, nwg, G, c, wgm, rot;
    __device__ __forceinline__ void init(int M, int N, int G_, int c_, int wgm_ = WGM, int rot_ = 0) { nM = M / BM; nN = N / BM; nwg = nM * nN; G = G_; c = c_; wgm = wgm_; rot = rot_; }
    __device__ __forceinline__ bool next(int i, Unit& u) const {
        const int rounds = nwg / G;
        if (rot) { if (i >= rounds) return false; i = i + rot; if (i >= rounds) i -= rounds; }
        const long L = (long)i * G + c; if (L >= nwg) return false;
        int wgid = (int)L; { const int q = nwg / NXCD, r = nwg % NXCD, xcd = wgid % NXCD, off = wgid / NXCD; wgid = (xcd < r ? xcd * (q + 1) : r * (q + 1) + (xcd - r) * q) + off; }
        const int nig = wgm * nN, gid = wgid / nig, fm = gid * wgm, gsz = (nM - fm) < wgm ? (nM - fm) : wgm;
        u.pm = fm + ((wgid % nig) % gsz); u.pn = (wgid % nig) / gsz; u.g = 0; return true;
    }
};
struct SchedWrap : SchedStd { __device__ __forceinline__ bool next(int i, Unit& u) const { const bool ok = SchedStd::next(i, u); u.pm &= 15; return ok; } };
struct SchedBatch {
    int nN, per, nwg, G, c;
    __device__ __forceinline__ void init(int ng, int nM_, int nN_, int G_, int c_) { nN = nN_; per = nM_ * nN_; nwg = ng * per; G = G_; c = c_; }
    __device__ __forceinline__ bool next(int i, Unit& u) const {
        const long L = (long)i * G + c; if (L >= nwg) return false;
        const int w = (int)(L % NXCD) * (nwg / NXCD) + (int)(L / NXCD);
        u.g = w / per; const int r = w % per; u.pm = r / nN; u.pn = r % nN; return true;
    }
};

struct SchedOne { Unit u; __device__ __forceinline__ bool next(int i, Unit& o) const { if (i > 0) return false; o = u; return true; } };

template <class Epi, class Sched>
__device__ __forceinline__ void gemm_phase(LAS unsigned char* lds, const GOp A, const GOp B, const int nt, const Sched& S, const Epi& E, const int wv) {
    const int tid = opaque_tid(wv), wid = __builtin_amdgcn_readfirstlane(tid >> 6), lane = tid & 63, wr = wid >> 2, wc = wid & 3, fr = lane & 15, fq = lane >> 4;
    unsigned voffA[2], voffB[2];
#pragma unroll
    for (int i = 0; i < 2; ++i) { int R, C; stage_rc(tid * 16 + i * 8192, R, C);
        const int Rb = Epi::NC ? (64 * (R >> 5) + perm32(R & 31)) : ((R & ~31) + perm32(R & 31));
        voffA[i] = (unsigned)R * A.rs + (unsigned)(C >> 4) * A.cs + (unsigned)(C & 15) * 2u;
        voffB[i] = (unsigned)Rb * B.rs + (unsigned)(C >> 4) * B.cs + (unsigned)(C & 15) * 2u; }
    const size_t kstepA = A.kstep, kstepB = B.kstep;
    const size_t hstepA = (size_t)HALF * A.rs, hstepB = (size_t)(Epi::NC ? 32 : HALF) * B.rs;
    const size_t tstepA = 2 * hstepA, tstepB = (size_t)BM * B.rs;
    const unsigned ldsw = (unsigned)wid * 1024u;
    const int aoff = lds_byte(wr * 64 + fr, fq * 8), boff = lds_byte(wc * 32 + fr, fq * 8);
#define PG8_SA(b, h) (((b) * 2 + (h)) * HTB)
#define PG8_SB(b, h) ((4 + (b) * 2 + (h)) * HTB)
#define PG8_STAGE(bufoff, gbase, voff) do { _Pragma("unroll") for (int _i = 0; _i < 2; ++_i) \
        __builtin_amdgcn_global_load_lds((const unsigned*)((const char*)(gbase) + (voff)[_i]), (LAS unsigned*)(lds + (bufoff) + ldsw + _i * 8192), 16, 0, 0); } while (0)
#define PG8_LDA(dst, b, h) do { _Pragma("unroll") for (int m = 0; m < 4; ++m) _Pragma("unroll") for (int k = 0; k < 2; ++k) dst[m][k] = *(const LAS bf16x8*)(lds + PG8_SA(b, h) + aoff + m * 2048 + k * 1024); } while (0)
#define PG8_LDB(dst, b, h) do { _Pragma("unroll") for (int n = 0; n < 2; ++n) _Pragma("unroll") for (int k = 0; k < 2; ++k) dst[n][k] = *(const LAS bf16x8*)(lds + PG8_SB(b, h) + boff + n * 2048 + k * 1024); } while (0)
#define PG8_MMA(ai, bj, At, Bt) do { __builtin_amdgcn_s_setprio(1); _Pragma("unroll") for (int m = 0; m < 4; ++m) _Pragma("unroll") for (int n = 0; n < 2; ++n) _Pragma("unroll") for (int k = 0; k < 2; ++k) \
        acc[ai][bj][m][n] = __builtin_amdgcn_mfma_f32_16x16x32_bf16(Bt[n][k], At[m][k], acc[ai][bj][m][n], 0, 0, 0); __builtin_amdgcn_s_setprio(0); } while (0)
#define PG8_WAIT_V(n) asm volatile("s_waitcnt vmcnt(" #n ")" ::: "memory")
#define PG8_WAIT_L(n) asm volatile("s_waitcnt lgkmcnt(" #n ")" ::: "memory")
#define PG8_BAR __builtin_amdgcn_s_barrier()
#define PG8_SCHED __builtin_amdgcn_sched_barrier(0)
    Unit cur, nxt; int ui = 0;
    if (!S.next(0, cur)) return;
    f32x4 acc[2][2][4][2];
#pragma unroll
    for (int a = 0; a < 2; ++a)
#pragma unroll
        for (int b = 0; b < 2; ++b)
#pragma unroll
            for (int m = 0; m < 4; ++m)
#pragma unroll
                for (int n = 0; n < 2; ++n) acc[a][b][m][n] = (f32x4){0.f, 0.f, 0.f, 0.f};
    bf16x8 At[4][2], B0[2][2], B1[2][2];
    const char* cA = A.base + (size_t)cur.g * A.gstride + (size_t)cur.pm * tstepA;
    const char* cB = B.base + (size_t)cur.g * B.gstride + (size_t)cur.pn * tstepB;
    PG8_STAGE(PG8_SB(0, 0), cB, voffB); PG8_STAGE(PG8_SB(0, 1), cB + hstepB, voffB); PG8_STAGE(PG8_SA(0, 0), cA, voffA); PG8_STAGE(PG8_SA(0, 1), cA + hstepA, voffA);
    if (wr == 1) PG8_BAR;
    PG8_WAIT_V(2); PG8_BAR;
    PG8_STAGE(PG8_SB(1, 0), cB + kstepB, voffB); PG8_STAGE(PG8_SA(1, 0), cA + kstepA, voffA); PG8_STAGE(PG8_SB(1, 1), cB + hstepB + kstepB, voffB);
    PG8_WAIT_V(6); PG8_BAR;
    for (;;) {
        const bool has_next = S.next(ui + 1, nxt);
        const char* nA = has_next ? A.base + (size_t)nxt.g * A.gstride + (size_t)nxt.pm * tstepA : cA;
        const char* nB = has_next ? B.base + (size_t)nxt.g * B.gstride + (size_t)nxt.pn * tstepB : cB;
        for (int t = 0; t < nt; t += 2) {
            const bool last = (t == nt - 2);
            const char* a1 = cA + (size_t)(t + 1) * kstepA;
            const char* a2 = last ? nA : cA + (size_t)(t + 2) * kstepA; const char* b2 = last ? nB : cB + (size_t)(t + 2) * kstepB;
            const char* a3 = a2 + kstepA; const char* b3 = b2 + kstepB;
            PG8_LDB(B0, 0, 0); PG8_LDB(B1, 0, 1); PG8_SCHED; PG8_LDA(At, 0, 0); PG8_STAGE(PG8_SA(1, 1), a1 + hstepA, voffA);
            PG8_WAIT_V(8); PG8_WAIT_L(0); PG8_BAR; PG8_MMA(0, 0, At, B0); PG8_MMA(0, 1, At, B1); PG8_BAR; PG8_SCHED;
            PG8_LDA(At, 0, 1); PG8_STAGE(PG8_SB(0, 0), b2, voffB); PG8_STAGE(PG8_SB(0, 1), b2 + hstepB, voffB); PG8_STAGE(PG8_SA(0, 0), a2, voffA);
            PG8_WAIT_V(8); PG8_WAIT_L(0); PG8_BAR; PG8_MMA(1, 0, At, B0); PG8_MMA(1, 1, At, B1); PG8_BAR; PG8_SCHED;
            PG8_LDB(B0, 1, 0); PG8_LDB(B1, 1, 1); PG8_SCHED; PG8_LDA(At, 1, 0); PG8_STAGE(PG8_SA(0, 1), a2 + hstepA, voffA);
            PG8_WAIT_V(8); PG8_WAIT_L(0); PG8_BAR; PG8_MMA(0, 0, At, B0); PG8_MMA(0, 1, At, B1); PG8_BAR; PG8_SCHED;
            PG8_LDA(At, 1, 1); PG8_STAGE(PG8_SB(1, 0), b3, voffB); PG8_STAGE(PG8_SB(1, 1), b3 + hstepB, voffB); PG8_STAGE(PG8_SA(1, 0), a3, voffA);
            PG8_WAIT_V(8); PG8_WAIT_L(0); PG8_BAR; PG8_MMA(1, 0, At, B0); PG8_MMA(1, 1, At, B1); PG8_BAR; PG8_SCHED;
        }
        if (wr == 0) PG8_BAR;
        if constexpr (!Epi::AFTER_DRAIN) E(acc, cur, wr, wc, fr, fq);
        if (!has_next) break;
#pragma unroll
        for (int a = 0; a < 2; ++a)
#pragma unroll
            for (int b = 0; b < 2; ++b)
#pragma unroll
                for (int m = 0; m < 4; ++m)
#pragma unroll
                    for (int n = 0; n < 2; ++n) acc[a][b][m][n] = (f32x4){0.f, 0.f, 0.f, 0.f};
        cur = nxt; cA = nA; cB = nB; ++ui;
        if (wr == 1) PG8_BAR;
    }
    PG8_WAIT_V(0);
    PG8_BAR;
    if constexpr (Epi::AFTER_DRAIN) E.fused(acc, cur, wr, wc, fr, fq, lds, tid);
#undef PG8_SA
#undef PG8_SB
#undef PG8_STAGE
#undef PG8_LDA
#undef PG8_LDB
#undef PG8_MMA
#undef PG8_WAIT_V
#undef PG8_WAIT_L
#undef PG8_BAR
#undef PG8_SCHED
}
}
using pg8::Unit;

typedef f32x4 AccT[2][2][4][2];

struct EpiNull {
    static constexpr bool PERM = true, AFTER_DRAIN = false, NC = true;
    __device__ __forceinline__ void operator()(const AccT& acc, const Unit& u, int wr, int wc, int fr, int fq) const {
#pragma unroll
        for (int ai = 0; ai < 2; ++ai)
#pragma unroll
            for (int bj = 0; bj < 2; ++bj)
#pragma unroll
                for (int m = 0; m < 4; ++m)
#pragma unroll
                    for (int n = 0; n < 2; ++n) asm volatile("" :: "v"(acc[ai][bj][m][n]));
    }
};

struct EpiInMain {
    static constexpr bool PERM = true, AFTER_DRAIN = false, NC = true;
    bf16_t* YC; bf16_t* XS; const u64* ssq; LAS unsigned char* lds;
    __device__ __forceinline__ void operator()(const AccT& acc, const Unit& u, int wr, int wc, int fr, int fq) const {
        const int rowb = u.pm * 256 + wr * 64 + fr;
        float rstd8[8];
        { u64 q8[8];
#pragma unroll
          for (int i = 0; i < 8; ++i) q8[i] = ssq[rowb + (i >> 2) * 128 + (i & 3) * 16];
#pragma unroll
          for (int i = 0; i < 8; ++i) rstd8[i] = rstd_of(q8[i]); }
        if (u.pn < 8) {
#pragma unroll
            for (int ai = 0; ai < 2; ++ai)
#pragma unroll
                for (int m = 0; m < 4; ++m) {
                    const int r = rowb + ai * 128 + m * 16;
                    const float rstd = rstd8[ai * 4 + m];
                    float o[8];
#pragma unroll
                    for (int n = 0; n < 2; ++n)
#pragma unroll
                        for (int j = 0; j < 4; ++j) {
                            const float uu = acc[ai][0][m][n][j] * rstd, zz = acc[ai][1][m][n][j] * rstd;
                            const float gu = uu * (1.0f + 0.044715f * uu * uu);
                            const float e1 = fexp2(gu * (-2.0f * 0.7978845608f * 1.4426950409f)), e2 = fexp2(zz * -1.4426950409f);
                            o[n * 4 + j] = (uu * zz) * frcp((1.0f + e1) * (1.0f + e2));
                        }
                    u32x4 w; w.x = cvt_pk_bf16(o[0], o[1]); w.y = cvt_pk_bf16(o[2], o[3]); w.z = cvt_pk_bf16(o[4], o[5]); w.w = cvt_pk_bf16(o[6], o[7]);
                    st16(YC + (size_t)r * 2048 + 128 * u.pn + 32 * wc + 8 * fq, w);
                }
        } else if (u.pn < 12) {
#pragma unroll
            for (int ai = 0; ai < 2; ++ai)
#pragma unroll
                for (int m = 0; m < 4; ++m) {
                    const int r = rowb + ai * 128 + m * 16;
                    const float rstd = rstd8[ai * 4 + m];
#pragma unroll
                    for (int bj = 0; bj < 2; ++bj) {
                        const int g = 16 * (u.pn - 8) + 4 * wc + 2 * bj + (fq >> 1);
                        const f32x4 v0 = acc[ai][bj][m][0] * rstd, v1 = acc[ai][bj][m][1] * rstd;
                        u32x4 w; w.x = cvt_pk_bf16(v0[0], v0[1]); w.y = cvt_pk_bf16(v0[2], v0[3]); w.z = cvt_pk_bf16(v1[0], v1[1]); w.w = cvt_pk_bf16(v1[2], v1[3]);
                        st16(XS + ((size_t)g * NCH + (r >> 5)) * XSK + (r & 31) * 16 + 8 * (fq & 1), w);
                    }
                }
        } else {
            LAS unsigned char* slab = lds + SLAB_OFF + (wr * 4 + wc) * SLAB_BYTES;
#pragma unroll
            for (int ai = 0; ai < 2; ++ai)
#pragma unroll
                for (int m = 0; m < 4; ++m) {
                    const float rstd = rstd8[ai * 4 + m];
                    u32x4 w[2];
#pragma unroll
                    for (int bj = 0; bj < 2; ++bj) {
                        float o[8];
#pragma unroll
                        for (int n = 0; n < 2; ++n)
#pragma unroll
                            for (int j = 0; j < 4; ++j) { const float zz = acc[ai][bj][m][n][j] * rstd; o[n * 4 + j] = zz * sigmoid_f(zz); }
                        w[bj].x = cvt_pk_bf16(o[0], o[1]); w[bj].y = cvt_pk_bf16(o[2], o[3]); w[bj].z = cvt_pk_bf16(o[4], o[5]); w[bj].w = cvt_pk_bf16(o[6], o[7]);
                    }
                    stage_store16(slab, fr, fq, w[0], w[1], YC + (size_t)(u.pm * 256 + wr * 64 + ai * 128 + m * 16) * 2048 + 1024 + 256 * (u.pn - 12) + 64 * wc, 2048);
                }
        }
    }
};

struct EpiInV {
    static constexpr bool PERM = true, AFTER_DRAIN = false, NC = true;
    bf16_t* GV; const u64* ssq; u64* vsum; u64* vsq; LAS unsigned char* lds;
    __device__ __forceinline__ void operator()(const AccT& acc, const Unit& u, int wr, int wc, int fr, int fq) const {
        f32x4 rs[2][2], s1[2][2], s2[2][2];
#pragma unroll
        for (int bj = 0; bj < 2; ++bj)
#pragma unroll
            for (int n = 0; n < 2; ++n) {
#pragma unroll
                for (int j = 0; j < 4; ++j) rs[bj][n][j] = rstd_of(ssq[u.pn * 256 + 64 * wc + 32 * bj + 8 * fq + 4 * n + j]);
                s1[bj][n] = (f32x4){0.f, 0.f, 0.f, 0.f}; s2[bj][n] = (f32x4){0.f, 0.f, 0.f, 0.f};
            }
        LAS unsigned char* slab = lds + SLAB_OFF + (wr * 4 + wc) * SLAB_BYTES;
#pragma unroll
        for (int ai = 0; ai < 2; ++ai)
#pragma unroll
            for (int m = 0; m < 4; ++m) {
                u32x4 w[2];
#pragma unroll
                for (int bj = 0; bj < 2; ++bj) {
                    f32x4 v[2];
#pragma unroll
                    for (int n = 0; n < 2; ++n) {
#pragma unroll
                        for (int j = 0; j < 4; ++j) v[n][j] = gelu_t(acc[ai][bj][m][n][j] * rs[bj][n][j]);
                        s1[bj][n] += v[n]; s2[bj][n] += v[n] * v[n];
                    }
                    w[bj].x = cvt_pk_bf16(v[0][0], v[0][1]); w[bj].y = cvt_pk_bf16(v[0][2], v[0][3]); w[bj].z = cvt_pk_bf16(v[1][0], v[1][1]); w[bj].w = cvt_pk_bf16(v[1][2], v[1][3]);
                }
                stage_store16(slab, fr, fq, w[0], w[1], GV + (size_t)(u.pm * 256 + ai * 128 + wr * 64 + m * 16) * TP + u.pn * 256 + 64 * wc, TP);
            }
        float v1[16], v2[16];
#pragma unroll
        for (int i = 0; i < 16; ++i) { v1[i] = s1[i >> 3][(i >> 2) & 1][i & 3]; v2[i] = s2[i >> 3][(i >> 2) & 1][i & 3]; }
#define RS_STEP(K) { const bool up = (fr & (K)) != 0; _Pragma("unroll") for (int i = 0; i < (K); ++i) { \
            const float k1 = up ? v1[i + (K)] : v1[i], g1 = up ? v1[i] : v1[i + (K)], k2 = up ? v2[i + (K)] : v2[i], g2 = up ? v2[i] : v2[i + (K)]; \
            v1[i] = k1 + __shfl_xor(g1, (K)); v2[i] = k2 + __shfl_xor(g2, (K)); } }
        RS_STEP(8) RS_STEP(4) RS_STEP(2) RS_STEP(1)
#undef RS_STEP
        { const int t = u.pn * 256 + 64 * wc + 32 * (fr >> 3) + 8 * fq + 4 * ((fr >> 2) & 1) + (fr & 3); atomicAdd(vsum + t, to_fx(v1[0], FX_V)); atomicAdd(vsq + t, to_fx(v2[0], FX_V)); }
    }
};

template <int ACT> struct EpiBf16 {
    static constexpr bool PERM = true, AFTER_DRAIN = false, NC = true;
    bf16_t* O; int ldc; size_t gstride; LAS unsigned char* lds;
    __device__ __forceinline__ void operator()(const AccT& acc, const Unit& u, int wr, int wc, int fr, int fq) const {
        bf16_t* base = O + (size_t)u.g * gstride + (size_t)(u.pm * 256 + wr * 64) * ldc + u.pn * 256 + 64 * wc;
        LAS unsigned char* slab = lds + SLAB_OFF + (wr * 4 + wc) * SLAB_BYTES;
#pragma unroll
        for (int ai = 0; ai < 2; ++ai)
#pragma unroll
            for (int m = 0; m < 4; ++m) {
                u32x4 w[2];
#pragma unroll
                for (int bj = 0; bj < 2; ++bj) {
                    f32x4 v0 = acc[ai][bj][m][0], v1 = acc[ai][bj][m][1];
                    if (ACT == 1) {
#pragma unroll
                        for (int j = 0; j < 4; ++j) { v0[j] = gelu_t(v0[j]); v1[j] = gelu_t(v1[j]); }
                    }
                    w[bj].x = cvt_pk_bf16(v0[0], v0[1]); w[bj].y = cvt_pk_bf16(v0[2], v0[3]); w[bj].z = cvt_pk_bf16(v1[0], v1[1]); w[bj].w = cvt_pk_bf16(v1[2], v1[3]);
                }
                stage_store16(slab, fr, fq, w[0], w[1], base + (size_t)(ai * 128 + m * 16) * ldc, (size_t)ldc);
            }
    }
};

struct EpiS1Scan {
    static constexpr bool PERM = true, AFTER_DRAIN = true, NC = false;
    bf16_t* XS; const float* AQ;
    __device__ __forceinline__ void fused(const AccT& acc, const Unit& u, int wr, int wc, int fr, int fq, LAS unsigned char* lds, int tid) const {
        LAS float* S = (LAS float*)lds;
        LAS f32x2* EE = (LAS f32x2*)(lds + 256 * 132 * 4);
        const int cps = u.pm < (TPROMPT / QC / 256) ? 64 : 128;
        const int p = tid & 63, seg = tid >> 6, nsps = cps >> 5, sidx = seg & (nsps - 1), seg0 = seg - sidx;
#pragma unroll
        for (int dir = 0; dir < 2; ++dir) {
#pragma unroll
            for (int ai = 0; ai < 2; ++ai)
#pragma unroll
                for (int m = 0; m < 4; ++m)
#pragma unroll
                    for (int n = 0; n < 2; ++n) *(LAS f32x4*)(S + (128 * ai + 64 * wr + 16 * m + fr) * 132 + 32 * wc + 8 * fq + 4 * n) = acc[ai][dir][m][n];
            asm volatile("s_waitcnt lgkmcnt(0)" ::: "memory"); __builtin_amdgcn_s_barrier(); asm volatile("" ::: "memory");
            const float ar = AQ[((u.g * 2 + dir) * 64 + p) * 2], ai_ = AQ[((u.g * 2 + dir) * 64 + p) * 2 + 1];
            float lr[32], li[32];
#pragma unroll
            for (int i = 0; i < 32; ++i) { const int cix = 32 * seg + (dir ? 31 - i : i); lr[i] = S[cix * 132 + p]; li[i] = S[cix * 132 + 64 + p]; }
            float er = 0.f, ei = 0.f;
#pragma unroll
            for (int i = 0; i < 32; ++i) { const float nr = ar * er - ai_ * ei + lr[i], ni = ar * ei + ai_ * er + li[i]; er = nr; ei = ni; }
            EE[seg * 64 + p] = (f32x2){er, ei};
            float br = ar, bi = ai_;
#pragma unroll
            for (int k = 0; k < 5; ++k) { const float nr = br * br - bi * bi, ni = 2.f * br * bi; br = nr; bi = ni; }
            asm volatile("s_waitcnt lgkmcnt(0)" ::: "memory"); __builtin_amdgcn_s_barrier(); asm volatile("" ::: "memory");
            float sr = 0.f, si = 0.f;
            const int nprev = dir ? (nsps - 1 - sidx) : sidx;
            for (int k = 0; k < nprev; ++k) { const int s2 = dir ? (seg0 + nsps - 1 - k) : (seg0 + k); const f32x2 e = EE[s2 * 64 + p];
                const float nr = br * sr - bi * si + e.x, ni = br * si + bi * sr + e.y; sr = nr; si = ni; }
            unsigned* xp = (unsigned*)(XS + ((size_t)u.g * NCH + (size_t)u.pm * 256 + 32 * seg) * XSK + 512 + dir * 128) + p;
#pragma unroll
            for (int i = 0; i < 32; ++i) { const int cl = dir ? 31 - i : i;
                xp[(size_t)cl * (XSK / 2)] = cvt_pk_bf16(sr, si);
                const float nr = ar * sr - ai_ * si + lr[i], ni = ar * si + ai_ * sr + li[i]; sr = nr; si = ni; }
            asm volatile("s_waitcnt lgkmcnt(0)" ::: "memory"); __builtin_amdgcn_s_barrier(); asm volatile("" ::: "memory");
        }
    }
};

struct EpiGlu {
    static constexpr bool PERM = true, AFTER_DRAIN = false, NC = true;
    const bf16_t* GY; bf16_t* YC; const float* bglu; LAS unsigned char* lds;
    __device__ __forceinline__ void operator()(const AccT& acc, const Unit& u, int wr, int wc, int fr, int fq) const {
        const int rowb = u.pm * 256 + wr * 64 + fr, cw = u.pn * 256 + 64 * wc;
        LAS unsigned char* slab = lds + SLAB_OFF + (wr * 4 + wc) * SLAB_BYTES;
        f32x4 bb[2][2];
#pragma unroll
        for (int bj = 0; bj < 2; ++bj) { bb[bj][0] = *(const f32x4*)(bglu + cw + 32 * bj + 8 * fq); bb[bj][1] = *(const f32x4*)(bglu + cw + 32 * bj + 8 * fq + 4); }
#pragma unroll
        for (int ai = 0; ai < 2; ++ai)
#pragma unroll
            for (int mp = 0; mp < 2; ++mp) {
                u32x4 gy[2][2], sz[2][2];
#pragma unroll
                for (int mm = 0; mm < 2; ++mm)
#pragma unroll
                    for (int bj = 0; bj < 2; ++bj) { const int r = rowb + ai * 128 + (2 * mp + mm) * 16, c0 = cw + 32 * bj + 8 * fq;
                        gy[mm][bj] = *(const u32x4*)(GY + ((size_t)(c0 >> 4) * TP + r) * 16 + (c0 & 15));
                        sz[mm][bj] = *(const u32x4*)(YC + (size_t)r * 2048 + 1024 + c0); }
                asm volatile("" ::: "memory");
#pragma unroll
                for (int mm = 0; mm < 2; ++mm) { const int m = 2 * mp + mm;
                    u32x4 w[2];
#pragma unroll
                    for (int bj = 0; bj < 2; ++bj) {
                        const f32x4 a0 = acc[ai][bj][m][0] + bb[bj][0], a1 = acc[ai][bj][m][1] + bb[bj][1]; const u32x4 g = gy[mm][bj], s = sz[mm][bj];
                        float o[8];
                        o[0] = bf_lo(g.x) * sigmoid_f(a0[0]) * bf_lo(s.x); o[1] = bf_hi(g.x) * sigmoid_f(a0[1]) * bf_hi(s.x);
                        o[2] = bf_lo(g.y) * sigmoid_f(a0[2]) * bf_lo(s.y); o[3] = bf_hi(g.y) * sigmoid_f(a0[3]) * bf_hi(s.y);
                        o[4] = bf_lo(g.z) * sigmoid_f(a1[0]) * bf_lo(s.z); o[5] = bf_hi(g.z) * sigmoid_f(a1[1]) * bf_hi(s.z);
                        o[6] = bf_lo(g.w) * sigmoid_f(a1[2]) * bf_lo(s.w); o[7] = bf_hi(g.w) * sigmoid_f(a1[3]) * bf_hi(s.w);
                        w[bj].x = cvt_pk_bf16(o[0], o[1]); w[bj].y = cvt_pk_bf16(o[2], o[3]); w[bj].z = cvt_pk_bf16(o[4], o[5]); w[bj].w = cvt_pk_bf16(o[6], o[7]);
                    }
                    stage_store16(slab, fr, fq, w[0], w[1], YC + (size_t)(u.pm * 256 + wr * 64 + ai * 128 + m * 16) * 2048 + 1024 + cw, 2048);
                }
                asm volatile("" ::: "memory");
            }
    }
};

struct EpiOut {
    static constexpr bool PERM = true, AFTER_DRAIN = false, NC = true;
    const float* xp; const float* xs; bf16_t* XB; u64* ssq_next; float* xf; LAS unsigned char* lds;
    __device__ __forceinline__ float sq8(const f32x4& y0, const f32x4& y1) const { return (y0[0] * y0[0] + y0[1] * y0[1]) + (y0[2] * y0[2] + y0[3] * y0[3]) + (y1[0] * y1[0] + y1[1] * y1[1]) + (y1[2] * y1[2] + y1[3] * y1[3]); }
    __device__ __forceinline__ void operator()(const AccT& acc, const Unit& u, int wr, int wc, int fr, int fq) const {
        const int rowb = u.pm * 256 + wr * 64 + fr, cw = u.pn * 256 + 64 * wc;
        LAS unsigned char* slab = lds + SLAB_OFF + (wr * 4 + wc) * SLAB_BYTES;
        float q[8];
#pragma unroll
        for (int i = 0; i < 8; ++i) q[i] = 0.f;
#pragma unroll
        for (int ai = 0; ai < 2; ++ai)
#pragma unroll
            for (int mp = 0; mp < 2; ++mp) {
                f32x4 x0[2][2], x1[2][2];
                if (xp) {
#pragma unroll
                    for (int mm = 0; mm < 2; ++mm)
#pragma unroll
                        for (int bj = 0; bj < 2; ++bj) { const int r = rowb + ai * 128 + (2 * mp + mm) * 16;
                            const float* b = (r < TPROMPT ? xp + (size_t)r * 1024 : xs + (size_t)(r - TPROMPT) * 1024) + cw + 32 * bj + 8 * fq; x0[mm][bj] = *(const f32x4*)b; x1[mm][bj] = *(const f32x4*)(b + 4); }
                } else {
                    u32x4 raw[2][2];
#pragma unroll
                    for (int mm = 0; mm < 2; ++mm)
#pragma unroll
                        for (int bj = 0; bj < 2; ++bj) raw[mm][bj] = *(const u32x4*)(XB + (size_t)(rowb + ai * 128 + (2 * mp + mm) * 16) * 1024 + cw + 32 * bj + 8 * fq);
#pragma unroll
                    for (int mm = 0; mm < 2; ++mm)
#pragma unroll
                        for (int bj = 0; bj < 2; ++bj) { const u32x4 w = raw[mm][bj];
                            x0[mm][bj] = (f32x4){bf_lo(w.x), bf_hi(w.x), bf_lo(w.y), bf_hi(w.y)}; x1[mm][bj] = (f32x4){bf_lo(w.z), bf_hi(w.z), bf_lo(w.w), bf_hi(w.w)}; }
                }
                asm volatile("" ::: "memory");
#pragma unroll
                for (int mm = 0; mm < 2; ++mm) { const int m = 2 * mp + mm;
                    const f32x4 y00 = x0[mm][0] + acc[ai][0][m][0], y01 = x1[mm][0] + acc[ai][0][m][1], y10 = x0[mm][1] + acc[ai][1][m][0], y11 = x1[mm][1] + acc[ai][1][m][1];
                    q[ai * 4 + m] = sq8(y00, y01) + sq8(y10, y11);
                    if (xf) { float* d = xf + (size_t)(rowb + ai * 128 + m * 16) * 1024 + cw + 8 * fq; *(f32x4*)d = y00; *(f32x4*)(d + 4) = y01; *(f32x4*)(d + 32) = y10; *(f32x4*)(d + 36) = y11; }
                    else { u32x4 w0, w1; w0.x = cvt_pk_bf16(y00[0], y00[1]); w0.y = cvt_pk_bf16(y00[2], y00[3]); w0.z = cvt_pk_bf16(y01[0], y01[1]); w0.w = cvt_pk_bf16(y01[2], y01[3]);
                        w1.x = cvt_pk_bf16(y10[0], y10[1]); w1.y = cvt_pk_bf16(y10[2], y10[3]); w1.z = cvt_pk_bf16(y11[0], y11[1]); w1.w = cvt_pk_bf16(y11[2], y11[3]);
                        stage_store16(slab, fr, fq, w0, w1, XB + (size_t)(u.pm * 256 + wr * 64 + ai * 128 + m * 16) * 1024 + cw, 1024); }
                }
                asm volatile("" ::: "memory");
            }
#pragma unroll
        for (int i = 0; i < 8; ++i) { const int r = rowb + (i >> 2) * 128 + (i & 3) * 16;
            float t = q[i]; t += __shfl_xor(t, 16); t += __shfl_xor(t, 32);
            if (fq == 0) atomicAdd(ssq_next + r, to_fx(t, FX_SSQ)); }
    }
};

struct Params { const float* in[20]; float* out; unsigned char* ws; int lo, hi; };
enum { I_XP = 0, I_XS, I_NORMG, I_WIN, I_LNG, I_LNB, I_WS, I_BS, I_LAMRE, I_LAMIM, I_LOGDT, I_BRE, I_BIM, I_CRE, I_CIM, I_DSKIP, I_WGLU, I_BGLU, I_WOUT, I_FINALG };

__device__ __forceinline__ void transpose_item(const float* W, int N, int k0, int n0, const float* scale, bf16_t* dst, int Kdst, LAS float* scr, int lane) {
    float tv[32];
#pragma unroll
    for (int i = 0; i < 32; ++i) tv[i] = W[(size_t)(k0 + 2 * i + (lane >> 5)) * N + n0 + (lane & 31)];
    if (scale) {
#pragma unroll
        for (int i = 0; i < 32; ++i) tv[i] *= scale[k0 + 2 * i + (lane >> 5)]; }
#pragma unroll
    for (int i = 0; i < 32; ++i) scr[(2 * i + (lane >> 5)) * 33 + (lane & 31)] = tv[i];
    asm volatile("s_waitcnt lgkmcnt(0)" ::: "memory");
    const int c = lane & 7;
#pragma unroll
    for (int j = 0; j < 4; ++j) { const int n = (lane >> 3) + 8 * j; const LAS float* s = scr + (8 * c) * 33 + n;
        u32x4 o; o.x = cvt_pk_bf16(s[0 * 33], s[1 * 33]); o.y = cvt_pk_bf16(s[2 * 33], s[3 * 33]); o.z = cvt_pk_bf16(s[4 * 33], s[5 * 33]); o.w = cvt_pk_bf16(s[6 * 33], s[7 * 33]);
        *(u32x4*)(dst + (size_t)n * Kdst + k0 + 8 * c) = o; }
    asm volatile("s_waitcnt lgkmcnt(0)" ::: "memory");
}

__device__ __forceinline__ void pre_phase(const Params& P, LAS unsigned char* lds, int tid, int lane, int wave) {
    unsigned char* ws = P.ws;
    {
        LAS float* scr = (LAS float*)(lds + wave * 8448);
        const int gw = blockIdx.x * 8 + wave, NGW = gridDim.x * 8;
        for (int it = gw; it < DEPTH * 4096; it += NGW) {
            const int l = it >> 12; int r = it & 4095;
            if (r < 2560) {
                const int kb = r / 160, nb = r % 160, sg = nb >> 5, b = nb & 31;
                int row;
                if (sg == 0) row = 256 * (b >> 2) + 64 * (b & 3);
                else if (sg == 1) row = 4096 + 32 * b;
                else if (sg == 2) row = 256 * (b >> 2) + 64 * (b & 3) + 32;
                else if (sg == 3) row = 2048 + 32 * b;
                else row = 3072 + 32 * b;
                transpose_item(P.in[I_WIN] + (size_t)l * 1024 * NIN, NIN, 64 * kb, 32 * nb, P.in[I_NORMG] + l * 1024,
                               (bf16_t*)(ws + WS_WIN) + ((size_t)l * NIN + row) * 1024, 1024, scr, lane);
            } else if (r < 3072) {
                r -= 2560; const int kb = r >> 5, nb = r & 31;
                transpose_item(P.in[I_WGLU] + (size_t)l * 1024 * 1024, 1024, 64 * kb, 32 * nb, nullptr,
                               (bf16_t*)(ws + WS_WGLU) + ((size_t)l * 1024 + 32 * nb) * 1024, 1024, scr, lane);
            } else {
                r -= 3072; const int kb = r >> 5, nb = r & 31;
                transpose_item(P.in[I_WOUT] + (size_t)l * 2048 * 1024, 1024, 64 * kb, 32 * nb, nullptr,
                               (bf16_t*)(ws + WS_WOUT) + ((size_t)l * 1024 + 32 * nb) * 2048, 2048, scr, lane);
            }
        }
    }
    {
        const float* src = P.in[I_WS]; bf16_t* dst = (bf16_t*)(ws + WS_WSB);
        for (int i = (blockIdx.x * NTHR + tid) * 8; i < DEPTH * 4 * 128 * 128; i += gridDim.x * NTHR * 8) {
            const f32x4 a = *(const f32x4*)(src + i), b = *(const f32x4*)(src + i + 4);
            u32x4 w; w.x = cvt_pk_bf16(a[0], a[1]); w.y = cvt_pk_bf16(a[2], a[3]); w.z = cvt_pk_bf16(b[0], b[1]); w.w = cvt_pk_bf16(b[2], b[3]);
            *(u32x4*)(dst + i) = w;
        }
    }
    {
        float* vec = (float*)(ws + WS_VEC);
        for (int i = blockIdx.x * NTHR + tid; i < VEC_N; i += gridDim.x * NTHR) {
            float v;
            if (i < VEC_LNB) v = P.in[I_LNG][i]; else if (i < VEC_BGLU) v = P.in[I_LNB][i - VEC_LNB]; else if (i < VEC_BS) v = P.in[I_BGLU][i - VEC_BGLU];
            else if (i < VEC_FG) v = P.in[I_BS][i - VEC_BS]; else v = P.in[I_FINALG][i - VEC_FG];
            vec[i] = v;
        }
    }
    __syncthreads();
    LAS f32x2* PW = (LAS f32x2*)lds;
    LAS f32x2* BB = (LAS f32x2*)(lds + 33792);
    LAS f32x2* CT = (LAS f32x2*)(lds + 33792 + 16384);
    LAS float* KT = (LAS float*)(lds + 33792 + 32768);
    LAS f32x2* FF = (LAS f32x2*)(lds + 33792 + 32768 + 65536);
    LAS float* DS = (LAS float*)(lds + 33792 + 32768 + 65536 + 1024);
    for (int lg = blockIdx.x; lg < DEPTH * 64; lg += gridDim.x) {
        const int l = lg >> 6, g = lg & 63;
        if (tid < 128) {
            const int p = tid & 63, dir = tid >> 6, ig = (l * 2 + dir) * 64 + g;
            const double dt = exp((double)P.in[I_LOGDT][ig]);
            const double lre = (double)P.in[I_LAMRE][ig * 64 + p], lim = (double)P.in[I_LAMIM][ig * 64 + p];
            const double mag = exp(lre * dt); double sn, cs; sincos(lim * dt, &sn, &cs);
            const double ar = mag * cs, ai = mag * sn;
            double zr = 1.0, zi = 0.0;
            for (int k = 0; k <= QC; ++k) { PW[(dir * 33 + k) * 64 + p] = (f32x2){(float)zr, (float)zi}; const double nr = zr * ar - zi * ai, ni = zr * ai + zi * ar; zr = nr; zi = ni; }
            const double nr = ar - 1.0, ni = ai, den = lre * lre + lim * lim;
            FF[dir * 64 + p] = (f32x2){(float)((nr * lre + ni * lim) / den), (float)((ni * lre - nr * lim) / den)};
        }
        for (int it = tid; it < 2 * 64 * 16; it += NTHR) {
            const int ch = it & 15, p = (it >> 4) & 63, dir = it >> 10;
            const size_t ci = ((size_t)((l * 2 + dir) * 64 + g) * 16 + ch) * 64 + p;
            CT[(dir * 64 + p) * 16 + ch] = (f32x2){P.in[I_CRE][ci], P.in[I_CIM][ci]};
        }
        if (tid < 16) DS[tid] = P.in[I_DSKIP][l * 1024 + g * 16 + tid];
        __syncthreads();
        for (int it = tid; it < 2 * 64 * 16; it += NTHR) {
            const int c = it & 15, p = (it >> 4) & 63, dir = it >> 10;
            const size_t bi = ((size_t)((l * 2 + dir) * 64 + g) * 64 + p) * 16 + c;
            const float br = P.in[I_BRE][bi], bm = P.in[I_BIM][bi]; const f32x2 f = FF[dir * 64 + p];
            BB[(dir * 64 + p) * 16 + c] = (f32x2){f.x * br - f.y * bm, f.x * bm + f.y * br};
        }
        __syncthreads();
        for (int it = tid; it < 2 * 32 * 16; it += NTHR) {
            const int ch = it & 15, lag = (it >> 4) & 31, dir = it >> 9;
            float a[16];
#pragma unroll
            for (int j = 0; j < 16; ++j) a[j] = 0.f;
            for (int p = 0; p < 64; ++p) {
                const f32x2 c = CT[(dir * 64 + p) * 16 + ch], w = PW[(dir * 33 + lag) * 64 + p];
                const float xr = c.x * w.x - c.y * w.y, xi = c.x * w.y + c.y * w.x;
                const LAS f32x4* bp = (const LAS f32x4*)(BB + (dir * 64 + p) * 16);
#pragma unroll
                for (int j = 0; j < 8; ++j) { const f32x4 b = bp[j]; a[2 * j] += xr * b[0] - xi * b[1]; a[2 * j + 1] += xr * b[2] - xi * b[3]; }
            }
            LAS f32x4* kp = (LAS f32x4*)(KT + ((dir * 32 + lag) * 16 + ch) * 16);
#pragma unroll
            for (int j = 0; j < 4; ++j) kp[j] = (f32x4){a[4 * j], a[4 * j + 1], a[4 * j + 2], a[4 * j + 3]};
        }
        __syncthreads();
        {
            bf16_t* W3 = (bf16_t*)(ws + WS_W3) + (size_t)lg * 512 * XSK;
            for (int it = tid; it < 512 * 96; it += NTHR) {
                const int kc = it % 96, n = it / 96, t = n >> 4, ch = n & 15, k0 = kc * 8;
                float v[8];
                if (k0 < 512) {
                    const int s = k0 >> 4, c0 = k0 & 15;
#pragma unroll
                    for (int j = 0; j < 8; ++j) {
                        float x = 0.f;
                        if (s <= t) x += KT[((0 * 32 + (t - s)) * 16 + ch) * 16 + c0 + j];
                        if (s >= t) x += KT[((1 * 32 + (s - t)) * 16 + ch) * 16 + c0 + j];
                        if (s == t && ch == c0 + j) x += DS[ch];
                        v[j] = x;
                    }
                } else {
                    const int q = k0 - 512, dir = q >> 7, p0 = (q & 127) >> 1, e = dir == 0 ? t + 1 : QC - t;
#pragma unroll
                    for (int j = 0; j < 8; ++j) {
                        const f32x2 c = CT[(dir * 64 + p0 + (j >> 1)) * 16 + ch], w = PW[(dir * 33 + e) * 64 + p0 + (j >> 1)];
                        v[j] = (j & 1) == 0 ? (c.x * w.x - c.y * w.y) : -(c.x * w.y + c.y * w.x);
                    }
                }
                u32x4 o; o.x = cvt_pk_bf16(v[0], v[1]); o.y = cvt_pk_bf16(v[2], v[3]); o.z = cvt_pk_bf16(v[4], v[5]); o.w = cvt_pk_bf16(v[6], v[7]);
                *(u32x4*)(W3 + (size_t)n * XSK + k0) = o;
            }
        }
        {
            bf16_t* W1 = (bf16_t*)(ws + WS_W1) + (size_t)lg * 256 * 512;
            for (int it = tid; it < 256 * 64; it += NTHR) {
                const int kc = it & 63, n = it >> 6, k0 = kc * 8, s = k0 >> 4, c0 = k0 & 15, dir = n >> 7, ri = (n >> 6) & 1, p = n & 63, e = dir == 0 ? (QC - 1 - s) : s;
                const f32x2 w = PW[(dir * 33 + e) * 64 + p];
                float v[8];
#pragma unroll
                for (int j = 0; j < 8; ++j) { const f32x2 b = BB[(dir * 64 + p) * 16 + c0 + j]; v[j] = ri == 0 ? (w.x * b.x - w.y * b.y) : (w.x * b.y + w.y * b.x); }
                u32x4 o; o.x = cvt_pk_bf16(v[0], v[1]); o.y = cvt_pk_bf16(v[2], v[3]); o.z = cvt_pk_bf16(v[4], v[5]); o.w = cvt_pk_bf16(v[6], v[7]);
                *(u32x4*)(W1 + (size_t)n * 512 + k0) = o;
            }
        }
        if (tid < 128) { const int dir = tid >> 6, p = tid & 63; const f32x2 w = PW[(dir * 33 + QC) * 64 + p];
            float* aq = (float*)(ws + WS_AQ) + ((size_t)(lg * 2 + dir) * 64 + p) * 2; aq[0] = w.x; aq[1] = w.y; }
        __syncthreads();
    }
}

__device__ __forceinline__ void p0_phase(const Params& P, int wv) {
    const int tid = opaque_tid(wv), lane = tid & 63, wave = __builtin_amdgcn_readfirstlane(tid >> 6), bid = opaque_bid();
    bf16_t* XB = (bf16_t*)(P.ws + WS_XB); u64* ssq = (u64*)(P.ws + WS_SSQ);
    for (int r = bid * 8 + wave; r < TP; r += gridDim.x * 8) {
        const float* src = r < TPROMPT ? P.in[I_XP] + (size_t)r * 1024 : P.in[I_XS] + (size_t)(r - TPROMPT) * 1024;
        const f32x4* xr = (const f32x4*)src + lane; u32x2* o = (u32x2*)(XB + (size_t)r * 1024) + lane;
        float s = 0.f;
#pragma unroll
        for (int j = 0; j < 4; ++j) { const f32x4 v = xr[64 * j]; s += (v[0] * v[0] + v[1] * v[1]) + (v[2] * v[2] + v[3] * v[3]); o[64 * j] = (u32x2){cvt_pk_bf16(v[0], v[1]), cvt_pk_bf16(v[2], v[3])}; }
        s = wave_sum(s);
        if (lane == 0) ssq[r] = to_fx(s, FX_SSQ);
    }
}
__device__ __forceinline__ void pz_phase(const Params& P, int wv) {
    const int tid = opaque_tid(wv), lane = tid & 63, wave = __builtin_amdgcn_readfirstlane(tid >> 6), bid = opaque_bid();
    const float* XF = (const float*)(P.ws + WS_XF); const u64* ssq = (const u64*)(P.ws + WS_SSQ) + (size_t)DEPTH * TP;
    const f32x4* fg = (const f32x4*)((const float*)(P.ws + WS_VEC) + VEC_FG) + lane;
    for (int r = bid * 8 + wave; r < TP; r += gridDim.x * 8) {
        const f32x4* xr = (const f32x4*)(XF + (size_t)r * 1024) + lane; f32x4* o = (f32x4*)(P.out + (size_t)r * 1024) + lane;
        const float rstd = rstd_of(ssq[r]);
#pragma unroll
        for (int j = 0; j < 4; ++j) o[64 * j] = xr[64 * j] * rstd * fg[64 * j];
    }
}

__device__ __forceinline__ void spatial_phase(unsigned char* ws, bf16_t* YC, LAS unsigned char* lds, int layer, bf16_t* dry, int wv) {
    const int tid = opaque_tid(wv);
    const int wave = __builtin_amdgcn_readfirstlane(tid >> 6), lane = tid & 63, fr = lane & 15, fq = lane >> 4;
    const int c = opaque_bid(), h = c & 3, wj = wave >> 1, wp = wave & 1;
    const bf16_t* GV = (const bf16_t*)(ws + WS_GV);
    const u64* vsum = (const u64*)(ws + WS_VSUM) + (size_t)layer * TP;
    const u64* vsq = (const u64*)(ws + WS_VSQ) + (size_t)layer * TP;
    const float* vec = (const float*)(ws + WS_VEC);
    const float* lng = vec + VEC_LNG + layer * 1024; const float* lnb = vec + VEC_LNB + layer * 1024; const float* bs = vec + VEC_BS + (layer * 4 + h) * 128;
    LAS unsigned char* WsL = lds; LAS unsigned char* GvL = lds + 34816;
    const int ch = tid & 15, r0 = tid >> 4;
    {
        const bf16_t* src = (const bf16_t*)(ws + WS_WSB) + (size_t)(layer * 4 + h) * 128 * 128;
#pragma unroll
        for (int i = 0; i < 4; ++i) { const int r = r0 + 32 * i; *(LAS u32x4*)(WsL + r * 272 + ch * 16) = *(const u32x4*)(src + r * 128 + ch * 8); }
    }
    float lg[8], lb[8];
#pragma unroll
    for (int ii = 0; ii < 8; ++ii) { lg[ii] = lng[256 * h + r0 + 32 * ii]; lb[ii] = lnb[256 * h + r0 + 32 * ii]; }
    float bsv[4];
#pragma unroll
    for (int pt = 0; pt < 4; ++pt) bsv[pt] = bs[64 * wp + 16 * pt + fr];
    const int cstride = (int)(gridDim.x >> 2), nchunks = TP / 128;
    LAS f32x2* ST = (LAS f32x2*)(lds + 34816 + 69632);
    for (int i = tid; i < ((nchunks - (c >> 2) + cstride - 1) / cstride) * 128; i += NTHR) {
        const int t = ((c >> 2) + (i >> 7) * cstride) * 128 + (i & 127);
        const float m = from_fx(vsum[t], (1.0f / FX_V) * (1.0f / 1024.0f)), q = from_fx(vsq[t], (1.0f / FX_V) * (1.0f / 1024.0f));
        ST[i] = (f32x2){m, rsqrtf(fmaxf(q - m * m, 0.f) + EPS)};
    }
    u32x4 raw[8];
#define SP_LOAD(CI) do { const int _t0 = (CI) * 128; _Pragma("unroll") for (int ii = 0; ii < 8; ++ii) raw[ii] = *(const u32x4*)(GV + (size_t)(256 * h + r0 + 32 * ii) * TP + _t0 + ch * 8); } while (0)
    int cidx = c >> 2, ui = 0;
    if (cidx < nchunks) SP_LOAD(cidx);
    for (; cidx < nchunks; cidx += cstride, ++ui) {
        const int t0 = cidx * 128;
        __syncthreads();
        float mu[8], rs[8];
#pragma unroll
        for (int k = 0; k < 8; ++k) { const f32x2 s = ST[ui * 128 + ch * 8 + k]; mu[k] = s.x; rs[k] = s.y; }
#pragma unroll
        for (int ii = 0; ii < 8; ++ii) {
            const int j = r0 + 32 * ii; const u32x4 w0 = raw[ii]; const float g = lg[ii], b = lb[ii];
            float y[8];
            y[0] = (bf_lo(w0.x) - mu[0]) * rs[0] * g + b; y[1] = (bf_hi(w0.x) - mu[1]) * rs[1] * g + b;
            y[2] = (bf_lo(w0.y) - mu[2]) * rs[2] * g + b; y[3] = (bf_hi(w0.y) - mu[3]) * rs[3] * g + b;
            y[4] = (bf_lo(w0.z) - mu[4]) * rs[4] * g + b; y[5] = (bf_hi(w0.z) - mu[5]) * rs[5] * g + b;
            y[6] = (bf_lo(w0.w) - mu[6]) * rs[6] * g + b; y[7] = (bf_hi(w0.w) - mu[7]) * rs[7] * g + b;
            u32x4 w; w.x = cvt_pk_bf16(y[0], y[1]); w.y = cvt_pk_bf16(y[2], y[3]); w.z = cvt_pk_bf16(y[4], y[5]); w.w = cvt_pk_bf16(y[6], y[7]);
            *(LAS u32x4*)(GvL + j * 272 + ch * 16) = w;
        }
        __syncthreads();
        if (cidx + cstride < nchunks) SP_LOAD(cidx + cstride);
        u32x4 p1[4][2];
#pragma unroll
        for (int pt = 0; pt < 4; ++pt)
#pragma unroll
            for (int u2 = 0; u2 < 2; ++u2) p1[pt][u2] = *(const u32x4*)(YC + (size_t)(t0 + 64 * wp + 16 * pt + fr) * 2048 + 256 * h + 64 * wj + 32 * u2 + 8 * fq);
        asm volatile("" ::: "memory");
        f32x4 acc[2][2][4];
#pragma unroll
        for (int a = 0; a < 2; ++a)
#pragma unroll
            for (int n = 0; n < 2; ++n)
#pragma unroll
                for (int pt = 0; pt < 4; ++pt) acc[a][n][pt] = (f32x4){0.f, 0.f, 0.f, 0.f};
#pragma unroll
        for (int ks = 0; ks < 4; ++ks) {
            bf16x8 av[2][2], bv[4];
#pragma unroll
            for (int u2 = 0; u2 < 2; ++u2)
#pragma unroll
                for (int n = 0; n < 2; ++n) { const int j = 64 * wj + 32 * u2 + 8 * (fr >> 2) + 4 * n + (fr & 3); av[u2][n] = *(const LAS bf16x8*)(GvL + j * 272 + ks * 64 + fq * 16); }
#pragma unroll
            for (int pt = 0; pt < 4; ++pt) { const int p = 64 * wp + 16 * pt + fr; bv[pt] = *(const LAS bf16x8*)(WsL + p * 272 + ks * 64 + fq * 16); }
#pragma unroll
            for (int u2 = 0; u2 < 2; ++u2)
#pragma unroll
                for (int n = 0; n < 2; ++n)
#pragma unroll
                    for (int pt = 0; pt < 4; ++pt) acc[u2][n][pt] = __builtin_amdgcn_mfma_f32_16x16x32_bf16(av[u2][n], bv[pt], acc[u2][n][pt], 0, 0, 0);
        }
#pragma unroll
        for (int pt = 0; pt < 4; ++pt) {
#pragma unroll
            for (int u2 = 0; u2 < 2; ++u2) {
                bf16_t* yp = YC + (size_t)(t0 + 64 * wp + 16 * pt + fr) * 2048 + 256 * h + 64 * wj + 32 * u2 + 8 * fq;
                const u32x4 pv = p1[pt][u2];
                const f32x4 d0 = acc[u2][0][pt] + bsv[pt], d1 = acc[u2][1][pt] + bsv[pt];
                u32x4 w;
                w.x = cvt_pk_bf16(bf_lo(pv.x) * d0[0], bf_hi(pv.x) * d0[1]); w.y = cvt_pk_bf16(bf_lo(pv.y) * d0[2], bf_hi(pv.y) * d0[3]);
                w.z = cvt_pk_bf16(bf_lo(pv.z) * d1[0], bf_hi(pv.z) * d1[1]); w.w = cvt_pk_bf16(bf_lo(pv.w) * d1[2], bf_hi(pv.w) * d1[3]);
                *(u32x4*)(dry ? dry + lane_id() * 8 : yp) = w;
            }
        }
        asm volatile("" ::: "memory");
    }
#undef SP_LOAD
    __syncthreads();
}

__global__ void __launch_bounds__(NTHR, 2) mk_fwd(Params P) {
    extern __shared__ __attribute__((aligned(16))) unsigned char lds_raw[];
    LAS unsigned char* lds = (LAS unsigned char*)lds_raw;
    volatile LAS unsigned* MISC = (volatile LAS unsigned*)(lds + MISC_OFF);
    const int tid = threadIdx.x, lane = tid & 63, wave = __builtin_amdgcn_readfirstlane(tid >> 6);
    if (tid < 64) MISC[tid] = 0u;
    __syncthreads();
    unsigned char* ws = P.ws;
    XcdBarrier bar; bar.bar = (unsigned*)(ws + WS_BAR); bar.x = 0; bar.st = MISC + 8;
    if (P.hi - P.lo > 1) bar = xcd_barrier_post((unsigned*)(ws + WS_BAR), MISC + 8);
    bar.wv = wave;
#define RUN(s) (P.lo <= (s) && (s) < P.hi)
#define SEAM(s) do { if (RUN(s) && RUN((s) + 1)) { xcd_barrier(bar); if (DUP == 12) xcd_barrier(bar); } } while (0)
    int step = 0;
    bf16_t* YC = (bf16_t*)P.out;
    if (RUN(step)) { for (int rr = 0; rr < (DUP == 9 ? 2 : 1); ++rr) { const int t2 = opaque_tid(wave); pre_phase(P, lds, t2, t2 & 63, wave); __syncthreads(); } p0_phase(P, wave); if (DUP == 10) p0_phase(P, wave); }
    SEAM(step); ++step;
    for (int layer = 0; layer < DEPTH; ++layer) {
        const u64* ssq = (const u64*)(ws + WS_SSQ) + (size_t)layer * TP;
        if (RUN(step)) for (int rr = 0; rr < ((DUP == 1 || DUP == 2) ? 2 : 1); ++rr) {
            if (rr == 0 || DUP == 1) {
                pg8::GOp A{(const char*)(ws + WS_XB), 2048u, 32u, 128, 0};
                pg8::GOp B{(const char*)(ws + WS_WIN) + (size_t)layer * NIN * 1024 * 2, 2048u, 32u, 128, 0};
                pg8::SchedStd S; { const int cb = opaque_bid(); S.init(TP, 4096, gridDim.x, cb, PA_WGM, PA_ROT * (cb & 7));
                  if (PA_STAGGER) { const unsigned long long t0 = __builtin_amdgcn_s_memrealtime(), dl = (unsigned long long)PA_STAGGER * ((cb >> 3) & 3); while (__builtin_amdgcn_s_memrealtime() - t0 < dl) __builtin_amdgcn_s_sleep(8); } }
                EpiInMain E{YC, (bf16_t*)(ws + WS_XS), ssq, lds};
                pg8::gemm_phase(lds, A, B, 16, S, E, wave);
            }
            if (DUP == 21 && rr == 0) {
                pg8::GOp A{(const char*)(ws + WS_XB), 2048u, 32u, 128, 0};
                pg8::GOp B{(const char*)(ws + WS_WIN) + (size_t)layer * NIN * 1024 * 2, 2048u, 32u, 128, 0};
                pg8::SchedWrap S; S.init(TP, 4096, gridDim.x, opaque_bid());
                EpiNull E{};
                pg8::gemm_phase(lds, A, B, 16, S, E, wave);
            }
            if (DUP == 11 && rr == 0) {
                pg8::GOp A{(const char*)(ws + WS_XB), 2048u, 32u, 128, 0};
                pg8::GOp B{(const char*)(ws + WS_WIN) + (size_t)layer * NIN * 1024 * 2, 2048u, 32u, 128, 0};
                pg8::SchedStd S; S.init(TP, 4096, gridDim.x, opaque_bid());
                EpiNull E{};
                pg8::gemm_phase(lds, A, B, 16, S, E, wave);
            }
            if (DUP == 15 && rr == 0) {
                pg8::GOp A{(const char*)(ws + WS_WIN) + ((size_t)layer * NIN + 4096) * 1024 * 2, 2048u, 32u, 128, 0};
                pg8::GOp B{(const char*)(ws + WS_XB), 2048u, 32u, 128, 0};
                pg8::SchedStd S; S.init(1024, TP, gridDim.x, opaque_bid());
                EpiNull E{};
                pg8::gemm_phase(lds, A, B, 16, S, E, wave);
            }
            if (rr == 0 || DUP == 2) {
                pg8::GOp A{(const char*)(ws + WS_WIN) + ((size_t)layer * NIN + 4096) * 1024 * 2, 2048u, 32u, 128, 0};
                pg8::GOp B{(const char*)(ws + WS_XB), 2048u, 32u, 128, 0};
                pg8::SchedStd S; S.init(1024, TP, gridDim.x, opaque_bid());
                EpiInV E{(bf16_t*)(ws + WS_GV), ssq, rr ? (u64*)(ws + WS_DUMMY + 1 * MiB) : (u64*)(ws + WS_VSUM) + (size_t)layer * TP, rr ? (u64*)(ws + WS_DUMMY + 2 * MiB) : (u64*)(ws + WS_VSQ) + (size_t)layer * TP, lds};
                pg8::gemm_phase(lds, A, B, 16, S, E, wave);
            }
        }
        SEAM(step); ++step;
        if (RUN(step)) {
            for (int rr = 0; rr < (DUP == 3 ? 2 : 1); ++rr)
            for (int rep = 0; rep < (64 * (NCH / 256)) / GRID; ++rep) {
                pg8::GOp A{(const char*)(ws + WS_XS), (unsigned)(XSK * 2), 32u, 128, (size_t)NCH * XSK * 2};
                pg8::GOp B{(const char*)(ws + WS_W1) + (size_t)layer * 64 * 256 * 512 * 2, 1024u, 32u, 128, (size_t)256 * 512 * 2};
                const int L = rep * GRID + opaque_bid(), nwg = 64 * (NCH / 256), w = (L % 8) * (nwg / 8) + L / 8;
                pg8::SchedOne S; S.u.g = w / (NCH / 256); S.u.pm = w % (NCH / 256); S.u.pn = 0;
                EpiS1Scan E{(bf16_t*)(ws + WS_XS), (const float*)(ws + WS_AQ) + (size_t)layer * 64 * 2 * 64 * 2};
                pg8::gemm_phase(lds, A, B, 8, S, E, wave);
            }
            if (DUP == 4) spatial_phase(ws, YC, lds, layer, (bf16_t*)(ws + WS_DUMMY), wave);
            spatial_phase(ws, YC, lds, layer, nullptr, wave);
        }
        SEAM(step); ++step;
        if (RUN(step)) for (int rr = 0; rr < (DUP == 6 ? 2 : 1); ++rr) {
            pg8::GOp A{(const char*)(ws + WS_XS), (unsigned)(XSK * 2), 32u, 128, (size_t)NCH * XSK * 2};
            pg8::GOp B{(const char*)(ws + WS_W3) + (size_t)layer * 64 * 512 * XSK * 2, (unsigned)(XSK * 2), 32u, 128, (size_t)512 * XSK * 2};
            pg8::SchedBatch S; S.init(64, NCH / 256, 2, gridDim.x, opaque_bid());
            if (DUP == 13 && rr == 0) { EpiNull E0{}; pg8::gemm_phase(lds, A, B, 12, S, E0, wave); }
            if (DUP == 22 && rr == 0) { EpiBf16<0> E0{(bf16_t*)(ws + WS_GV), 512, (size_t)NCH * 512, lds}; pg8::gemm_phase(lds, A, B, 12, S, E0, wave); }
            EpiBf16<1> E{(bf16_t*)(ws + WS_GV), 512, (size_t)NCH * 512, lds};
            pg8::gemm_phase(lds, A, B, 12, S, E, wave);
        }
        SEAM(step); ++step;
        if (RUN(step)) for (int rr = 0; rr < 1; ++rr) {
            pg8::GOp A{(const char*)(ws + WS_GV), 32u, (unsigned)(TP * 32), (size_t)4 * TP * 32, 0};
            pg8::GOp B{(const char*)(ws + WS_WGLU) + (size_t)layer * 1024 * 1024 * 2, 2048u, 32u, 128, 0};
            pg8::SchedStd S; S.init(TP, 1024, gridDim.x, opaque_bid());
            if (DUP == 14 && rr == 0) { EpiNull E0{}; pg8::gemm_phase(lds, A, B, 16, S, E0, wave); }
            EpiGlu E{(const bf16_t*)(ws + WS_GV), YC, (const float*)(ws + WS_VEC) + VEC_BGLU + layer * 1024, lds};
            pg8::gemm_phase(lds, A, B, 16, S, E, wave);
        }
        SEAM(step); ++step;
        if (RUN(step)) for (int rr = 0; rr < 1; ++rr) {
            pg8::GOp A{(const char*)YC, 4096u, 32u, 128, 0};
            pg8::GOp B{(const char*)(ws + WS_WOUT) + (size_t)layer * 1024 * 2048 * 2, 4096u, 32u, 128, 0};
            pg8::SchedStd S; S.init(TP, 1024, gridDim.x, opaque_bid());
            if (DUP == 16 && rr == 0) { EpiNull E0{}; pg8::gemm_phase(lds, A, B, 32, S, E0, wave); }
            EpiOut E{layer == 0 ? P.in[I_XP] : nullptr, P.in[I_XS], (bf16_t*)(ws + WS_XB), (u64*)(ws + WS_SSQ) + (size_t)(layer + 1) * TP, layer == DEPTH - 1 ? (float*)(ws + WS_XF) : nullptr, lds};
            pg8::gemm_phase(lds, A, B, 32, S, E, wave);
        }
        SEAM(step); ++step;
    }
    if (RUN(step)) pz_phase(P, wave);
    ++step;
#undef RUN
#undef SEAM
}

extern "C" void kernel_launch(void* const* d_in, const int* in_sizes, int n_in, void* d_out, int out_size, void* d_ws, size_t ws_size, hipStream_t stream) {
    static int ready = 0;
    if (ready == 0) {
        if (n_in != 20 || out_size != TALL * D || ws_size < WS_END) { fprintf(stderr, "kernel_launch: unexpected shapes (n_in %d, out %d, ws %zu)\n", n_in, out_size, ws_size); ready = -1; return; }
        if (hipFuncSetAttribute((const void*)mk_fwd, hipFuncAttributeMaxDynamicSharedMemorySize, LDS_BYTES) != hipSuccess) { fprintf(stderr, "kernel_launch: hipFuncSetAttribute failed\n"); ready = -1; return; }
        ready = 1;
    }
    if (ready < 0) return;
    (void)hipMemsetAsync(d_ws, 0, ZERO_BYTES, stream);
    Params p{};
    for (int i = 0; i < 20; ++i) p.in[i] = (const float*)d_in[i];
    p.out = (float*)d_out; p.ws = (unsigned char*)d_ws;
#if MK_ONE_LAUNCH
    p.lo = 0; p.hi = NSTEPS;
    hipLaunchKernelGGL(mk_fwd, dim3(GRID), dim3(NTHR), LDS_BYTES, stream, p);
#else
    for (int s = 0; s < NSTEPS; ++s) { p.lo = s; p.hi = s + 1; hipLaunchKernelGGL(mk_fwd, dim3(GRID), dim3(NTHR), LDS_BYTES, stream, p); }
#endif
}
```

```cpp
#include <hip/hip_runtime.h>
#include <cstdio>
#include <cstdint>

#ifndef MK_ONE_LAUNCH
#define MK_ONE_LAUNCH 1
#endif

#define LAS __attribute__((address_space(3)))
typedef unsigned short bf16_t;
typedef short bf16x8 __attribute__((ext_vector_type(8)));
typedef float f32x4 __attribute__((ext_vector_type(4)));
typedef float f32x2 __attribute__((ext_vector_type(2)));
typedef unsigned u32x4 __attribute__((ext_vector_type(4)));
typedef unsigned u32x2 __attribute__((ext_vector_type(2)));

constexpr int D = 1024, DEPTH = 4, TALL = 98304, TP = 98304  , TPROMPT = 32768, QC = 32, NCH = TP / QC  ;
constexpr int NIN = 5120, XSK = 768  ;
constexpr float EPS = 1e-6f;
constexpr int GRID = 256, NTHR = 512;
constexpr int NSTEPS = 1 + DEPTH * 5 + 1;

constexpr size_t MiB = 1u << 20, KiB = 1u << 10;
constexpr size_t WS_BAR = 0;
constexpr size_t WS_SSQ = 64 * KiB;
constexpr size_t WS_VSUM = WS_SSQ + (size_t)(DEPTH + 1) * TP * 8;
constexpr size_t WS_VSQ = WS_VSUM + (size_t)DEPTH * TP * 8;
constexpr size_t ZERO_BYTES = WS_VSQ + (size_t)DEPTH * TP * 8;
static_assert(ZERO_BYTES % 16 == 0 && ZERO_BYTES <= 11 * MiB, "zero region");
constexpr size_t WS_VEC = 11 * MiB;
constexpr int VEC_LNG = 0, VEC_LNB = 4096, VEC_BGLU = 8192, VEC_BS = 12288, VEC_FG = 14336, VEC_N = 15360;
constexpr size_t WS_AQ = 11 * MiB + 512 * KiB;
constexpr size_t WS_WSB = 12 * MiB;
constexpr size_t WS_WIN = 13 * MiB;
constexpr size_t WS_WGLU = 53 * MiB;
constexpr size_t WS_WOUT = 61 * MiB;
constexpr size_t WS_W1 = 77 * MiB;
constexpr size_t WS_W3 = 141 * MiB;
constexpr size_t WS_XB = 333 * MiB;
constexpr size_t WS_GV = 525 * MiB;
constexpr size_t WS_XS = 717 * MiB;
constexpr size_t WS_XF = WS_GV;
constexpr size_t WS_END = 1005 * MiB;

constexpr int LDS_BYTES = 151552;
constexpr int SLAB_OFF = 131072, SLAB_BYTES = 2304;
constexpr int MISC_OFF = LDS_BYTES - 256;

__device__ __forceinline__ unsigned cvt_pk_bf16(float lo, float hi) { unsigned r; asm volatile("v_cvt_pk_bf16_f32 %0, %1, %2" : "=v"(r) : "v"(lo), "v"(hi)); return r; }
__device__ __forceinline__ float bf_lo(unsigned w) { return __uint_as_float(w << 16); }
__device__ __forceinline__ float bf_hi(unsigned w) { return __uint_as_float(w & 0xffff0000u); }
__device__ __forceinline__ float bf2f(bf16_t b) { return __uint_as_float(((unsigned)b) << 16); }
__device__ __forceinline__ bf16_t f2bf(float f) { return (bf16_t)(cvt_pk_bf16(f, 0.f) & 0xffffu); }
__device__ __forceinline__ float fexp2(float x) { return __builtin_amdgcn_exp2f(x); }
__device__ __forceinline__ float frcp(float x) { return __builtin_amdgcn_rcpf(x); }
__device__ __forceinline__ float gelu_t(float x) {
    const float u = x * (1.0f + 0.044715f * x * x);
    return x * frcp(1.0f + fexp2(u * (-2.0f * 0.7978845608f * 1.4426950409f)));
}
__device__ __forceinline__ float sigmoid_f(float z) { return frcp(1.0f + fexp2(z * -1.4426950409f)); }
__device__ __forceinline__ void st16(void* p, u32x4 v) { *(u32x4*)p = v; }
__device__ __forceinline__ void stage_store16(LAS unsigned char* slab, int fr, int fq, u32x4 w0, u32x4 w1, bf16_t* row0, size_t ld) {
    *(LAS u32x4*)(slab + fr * 144 + fq * 16) = w0; *(LAS u32x4*)(slab + fr * 144 + 64 + fq * 16) = w1;
    asm volatile("s_waitcnt lgkmcnt(0)" ::: "memory");
    const int l = fq * 16 + fr;
    const u32x4 a = *(const LAS u32x4*)(slab + (l >> 3) * 144 + (l & 7) * 16), b = *(const LAS u32x4*)(slab + (8 + (l >> 3)) * 144 + (l & 7) * 16);
    asm volatile("s_waitcnt lgkmcnt(0)" ::: "memory");
    st16(row0 + (size_t)(l >> 3) * ld + (l & 7) * 8, a); st16(row0 + (size_t)(8 + (l >> 3)) * ld + (l & 7) * 8, b);
}
typedef unsigned long long u64;
constexpr float FX_SSQ = 16777216.0f  , FX_V = 4294967296.0f  ;
__device__ __forceinline__ u64 to_fx(float v, float scale) { return (u64)(long long)(v * scale); }
__device__ __forceinline__ float from_fx(u64 x, float inv_scale) { return (float)(long long)x * inv_scale; }
__device__ __forceinline__ float rstd_of(u64 ssq_fx) { return rsqrtf(from_fx(ssq_fx, (1.0f / FX_SSQ) * (1.0f / 1024.0f)) + EPS); }
__device__ __forceinline__ float wave_sum(float v) {
#pragma unroll
    for (int o = 1; o < 64; o <<= 1) v += __shfl_xor(v, o);
    return v;
}

__device__ __forceinline__ int lane_id() { int l; asm volatile("v_mbcnt_lo_u32_b32 %0, -1, 0\n\tv_mbcnt_hi_u32_b32 %0, -1, %0" : "=v"(l)); return l; }
__device__ __forceinline__ int opaque_tid(int wv) { int t = wv * 64 + lane_id(); asm volatile("" : "+v"(t)); return t; }
__device__ __forceinline__ int opaque_bid() { int b = blockIdx.x; asm volatile("" : "+s"(b)); return b; }

#define XB_TMO      128
#define XB_XCNT(j)  (256  + 64 * (j))
#define XB_XSUB(j)  (1280 + 64 * (j))
#define XB_XGEN(j)  (2304 + 64 * (j))
#define XB_TOP      3328
#define XB_TOPGEN   3392
#define XCD_BAR_WORDS 3456
#define XB_SPIN_CAP (1u << 18)
__device__ __forceinline__ unsigned xb_ld(unsigned* p)              { return __hip_atomic_load(p, __ATOMIC_RELAXED, __HIP_MEMORY_SCOPE_AGENT); }
__device__ __forceinline__ unsigned xb_add(unsigned* p, unsigned v) { return __hip_atomic_fetch_add(p, v, __ATOMIC_RELAXED, __HIP_MEMORY_SCOPE_AGENT); }
__device__ __forceinline__ unsigned xb_xcc_id() { return (unsigned)__builtin_amdgcn_s_getreg((3 << 11) | 20) & 0xFu; }
#define XB_SPIN(cond, bar) do { unsigned _sp = 0; while (cond) { __builtin_amdgcn_s_sleep(1); \
    if ((++_sp & 255u) == 0u) { if (xb_ld(&(bar)[XB_TMO])) break; if (_sp > XB_SPIN_CAP) { atomicAdd(&(bar)[XB_TMO], 1u); break; } } } } while (0)
struct XcdBarrier { unsigned* bar; unsigned x; volatile LAS unsigned* st; int wv; };
__device__ __forceinline__ XcdBarrier xcd_barrier_post(unsigned* bar, volatile LAS unsigned* st) {
    XcdBarrier b; b.bar = bar; b.x = xb_xcc_id(); b.st = st; b.wv = 0;
    if (threadIdx.x == 0) (void)xb_add(&bar[XB_XCNT(b.x)], 1u);
    return b;
}
__device__ __forceinline__ void xcd_barrier_complete(unsigned* bar, unsigned x, unsigned& nloc, unsigned& nx) {
    const unsigned G = gridDim.x * gridDim.y * gridDim.z;
    unsigned sum, cnt, mine, sp = 0u;
    for (;;) {
        sum = 0u; cnt = 0u; mine = 0u;
#pragma unroll
        for (unsigned j = 0; j < 16; ++j) { const unsigned c = xb_ld(&bar[XB_XCNT(j)]); sum += c; cnt += (c > 0u) ? 1u : 0u; mine = (j == x) ? c : mine; }
        if (sum == G) break;
        __builtin_amdgcn_s_sleep(1);
        if ((++sp & 255u) == 0u) { if (xb_ld(&bar[XB_TMO])) break; if (sp > XB_SPIN_CAP) { atomicAdd(&bar[XB_TMO], 1u); break; } }
    }
    nloc = mine > 0u ? mine : 1u; nx = cnt > 0u ? cnt : 1u;
}
__device__ __forceinline__ void xcd_barrier(const XcdBarrier& b) {
    asm volatile("s_waitcnt vmcnt(0)" ::: "memory");
    __syncthreads();
    if (b.wv == 0 && lane_id() == 0) {
        unsigned* bar = b.bar;
        __builtin_amdgcn_s_waitcnt(0);
        unsigned nloc = b.st[0], nx = b.st[1];
        if (nloc == 0u) { xcd_barrier_complete(bar, b.x, nloc, nx); b.st[0] = nloc; b.st[1] = nx; }
        const unsigned old = xb_add(&bar[XB_XSUB(b.x)], 1u);
        const unsigned gen = old / nloc;
        if (old + 1u == (gen + 1u) * nloc) {
            __builtin_amdgcn_fence(__ATOMIC_RELEASE, "agent");
            asm volatile("s_waitcnt vmcnt(0)" ::: "memory");
            const unsigned og = xb_add(&bar[XB_TOP], 1u);
            const unsigned tg = og / nx;
            if (og + 1u == (tg + 1u) * nx) xb_add(&bar[XB_TOPGEN], 1u);
            else XB_SPIN(xb_ld(&bar[XB_TOPGEN]) == tg, bar);
            __builtin_amdgcn_fence(__ATOMIC_ACQUIRE, "agent");
            xb_add(&bar[XB_XGEN(b.x)], 1u);
            asm volatile("s_waitcnt vmcnt(0)" ::: "memory");
        } else {
            XB_SPIN(xb_ld(&bar[XB_XGEN(b.x)]) == gen, bar);
            __builtin_amdgcn_fence(__ATOMIC_ACQUIRE, "agent");
            asm volatile("s_waitcnt vmcnt(0)" ::: "memory");
        }
    }
    __syncthreads();
}

namespace pg8 {
constexpr int BM = 256, BK = 64, HALF = 128, HTB = HALF * BK * 2, STAGE_BYTES = 8 * HTB, NXCD = 8, WGM = 8;
__host__ __device__ __forceinline__ int lds_byte(int r, int c) { const int st = (r >> 4) * 2 + (c >> 5), rr = r & 15, cc = c & 31, ob = rr * 64 + cc * 2; return st * 1024 + (ob ^ (((ob >> 9) & 1) << 5)); }
__host__ __device__ __forceinline__ void stage_rc(int b, int& R, int& C) { const int st = b / 1024, sb = b % 1024, swz = sb ^ (((sb >> 9) & 1) << 5); R = (st >> 1) * 16 + swz / 64; C = (st & 1) * 32 + (swz % 64) / 2; }
__host__ __device__ __forceinline__ int perm32(int rho) { const int n = rho >> 4, i = rho & 15; return 8 * (i >> 2) + 4 * n + (i & 3); }

struct Unit { int pm, pn, g; };
struct GOp { const char* base; unsigned rs, cs; size_t kstep, gstride; };

struct SchedStd {
    int nM, nN, nwg, G, c;
    __device__ __forceinline__ void init(int M, int N, int G_, int c_) { nM = M / BM; nN = N / BM; nwg = nM * nN; G = G_; c = c_; }
    __device__ __forceinline__ bool next(int i, Unit& u) const {
        const long L = (long)i * G + c; if (L >= nwg) return false;
        int wgid = (int)L; { const int q = nwg / NXCD, r = nwg % NXCD, xcd = wgid % NXCD, off = wgid / NXCD; wgid = (xcd < r ? xcd * (q + 1) : r * (q + 1) + (xcd - r) * q) + off; }
        const int nig = WGM * nN, gid = wgid / nig, fm = gid * WGM, gsz = (nM - fm) < WGM ? (nM - fm) : WGM;
        u.pm = fm + ((wgid % nig) % gsz); u.pn = (wgid % nig) / gsz; u.g = 0; return true;
    }
};
struct SchedBatch {
    int nN, per, nwg, G, c;
    __device__ __forceinline__ void init(int ng, int nM_, int nN_, int G_, int c_) { nN = nN_; per = nM_ * nN_; nwg = ng * per; G = G_; c = c_; }
    __device__ __forceinline__ bool next(int i, Unit& u) const {
        const long L = (long)i * G + c; if (L >= nwg) return false;
        const int w = (int)(L % NXCD) * (nwg / NXCD) + (int)(L / NXCD);
        u.g = w / per; const int r = w % per; u.pm = r / nN; u.pn = r % nN; return true;
    }
};

struct SchedOne { Unit u; __device__ __forceinline__ bool next(int i, Unit& o) const { if (i > 0) return false; o = u; return true; } };

template <class Epi, class Sched>
__device__ __forceinline__ void gemm_phase(LAS unsigned char* lds, const GOp A, const GOp B, const int nt, const Sched& S, const Epi& E, const int wv) {
    const int tid = opaque_tid(wv), wid = __builtin_amdgcn_readfirstlane(tid >> 6), lane = tid & 63, wr = wid >> 2, wc = wid & 3, fr = lane & 15, fq = lane >> 4;
    unsigned voffA[2], voffB[2];
#pragma unroll
    for (int i = 0; i < 2; ++i) { int R, C; stage_rc(tid * 16 + i * 8192, R, C);
        const int Rb = Epi::NC ? (64 * (R >> 5) + perm32(R & 31)) : ((R & ~31) + perm32(R & 31));
        voffA[i] = (unsigned)R * A.rs + (unsigned)(C >> 4) * A.cs + (unsigned)(C & 15) * 2u;
        voffB[i] = (unsigned)Rb * B.rs + (unsigned)(C >> 4) * B.cs + (unsigned)(C & 15) * 2u; }
    const size_t kstepA = A.kstep, kstepB = B.kstep;
    const size_t hstepA = (size_t)HALF * A.rs, hstepB = (size_t)(Epi::NC ? 32 : HALF) * B.rs;
    const size_t tstepA = 2 * hstepA, tstepB = (size_t)BM * B.rs;
    const unsigned ldsw = (unsigned)wid * 1024u;
    const int aoff = lds_byte(wr * 64 + fr, fq * 8), boff = lds_byte(wc * 32 + fr, fq * 8);
#define PG8_SA(b, h) (((b) * 2 + (h)) * HTB)
#define PG8_SB(b, h) ((4 + (b) * 2 + (h)) * HTB)
#define PG8_STAGE(bufoff, gbase, voff) do { _Pragma("unroll") for (int _i = 0; _i < 2; ++_i) \
        __builtin_amdgcn_global_load_lds((const unsigned*)((const char*)(gbase) + (voff)[_i]), (LAS unsigned*)(lds + (bufoff) + ldsw + _i * 8192), 16, 0, 0); } while (0)
#define PG8_LDA(dst, b, h) do { _Pragma("unroll") for (int m = 0; m < 4; ++m) _Pragma("unroll") for (int k = 0; k < 2; ++k) dst[m][k] = *(const LAS bf16x8*)(lds + PG8_SA(b, h) + aoff + m * 2048 + k * 1024); } while (0)
#define PG8_LDB(dst, b, h) do { _Pragma("unroll") for (int n = 0; n < 2; ++n) _Pragma("unroll") for (int k = 0; k < 2; ++k) dst[n][k] = *(const LAS bf16x8*)(lds + PG8_SB(b, h) + boff + n * 2048 + k * 1024); } while (0)
#define PG8_MMA(ai, bj, At, Bt) do { __builtin_amdgcn_s_setprio(1); _Pragma("unroll") for (int m = 0; m < 4; ++m) _Pragma("unroll") for (int n = 0; n < 2; ++n) _Pragma("unroll") for (int k = 0; k < 2; ++k) \
        acc[ai][bj][m][n] = __builtin_amdgcn_mfma_f32_16x16x32_bf16(Bt[n][k], At[m][k], acc[ai][bj][m][n], 0, 0, 0); __builtin_amdgcn_s_setprio(0); } while (0)
#define PG8_WAIT_V(n) asm volatile("s_waitcnt vmcnt(" #n ")" ::: "memory")
#define PG8_WAIT_L(n) asm volatile("s_waitcnt lgkmcnt(" #n ")" ::: "memory")
#define PG8_BAR __builtin_amdgcn_s_barrier()
#define PG8_SCHED __builtin_amdgcn_sched_barrier(0)
    Unit cur, nxt; int ui = 0;
    if (!S.next(0, cur)) return;
    f32x4 acc[2][2][4][2];
#pragma unroll
    for (int a = 0; a < 2; ++a)
#pragma unroll
        for (int b = 0; b < 2; ++b)
#pragma unroll
            for (int m = 0; m < 4; ++m)
#pragma unroll
                for (int n = 0; n < 2; ++n) acc[a][b][m][n] = (f32x4){0.f, 0.f, 0.f, 0.f};
    bf16x8 At[4][2], B0[2][2], B1[2][2];
    const char* cA = A.base + (size_t)cur.g * A.gstride + (size_t)cur.pm * tstepA;
    const char* cB = B.base + (size_t)cur.g * B.gstride + (size_t)cur.pn * tstepB;
    PG8_STAGE(PG8_SB(0, 0), cB, voffB); PG8_STAGE(PG8_SB(0, 1), cB + hstepB, voffB); PG8_STAGE(PG8_SA(0, 0), cA, voffA); PG8_STAGE(PG8_SA(0, 1), cA + hstepA, voffA);
    if (wr == 1) PG8_BAR;
    PG8_WAIT_V(2); PG8_BAR;
    PG8_STAGE(PG8_SB(1, 0), cB + kstepB, voffB); PG8_STAGE(PG8_SA(1, 0), cA + kstepA, voffA); PG8_STAGE(PG8_SB(1, 1), cB + hstepB + kstepB, voffB);
    PG8_WAIT_V(6); PG8_BAR;
    for (;;) {
        const bool has_next = S.next(ui + 1, nxt);
        const char* nA = has_next ? A.base + (size_t)nxt.g * A.gstride + (size_t)nxt.pm * tstepA : cA;
        const char* nB = has_next ? B.base + (size_t)nxt.g * B.gstride + (size_t)nxt.pn * tstepB : cB;
        for (int t = 0; t < nt; t += 2) {
            const bool last = (t == nt - 2);
            const char* a1 = cA + (size_t)(t + 1) * kstepA;
            const char* a2 = last ? nA : cA + (size_t)(t + 2) * kstepA; const char* b2 = last ? nB : cB + (size_t)(t + 2) * kstepB;
            const char* a3 = a2 + kstepA; const char* b3 = b2 + kstepB;
            PG8_LDB(B0, 0, 0); PG8_LDB(B1, 0, 1); PG8_SCHED; PG8_LDA(At, 0, 0); PG8_STAGE(PG8_SA(1, 1), a1 + hstepA, voffA);
            PG8_WAIT_V(8); PG8_WAIT_L(0); PG8_BAR; PG8_MMA(0, 0, At, B0); PG8_MMA(0, 1, At, B1); PG8_BAR; PG8_SCHED;
            PG8_LDA(At, 0, 1); PG8_STAGE(PG8_SB(0, 0), b2, voffB); PG8_STAGE(PG8_SB(0, 1), b2 + hstepB, voffB); PG8_STAGE(PG8_SA(0, 0), a2, voffA);
            PG8_WAIT_V(8); PG8_WAIT_L(0); PG8_BAR; PG8_MMA(1, 0, At, B0); PG8_MMA(1, 1, At, B1); PG8_BAR; PG8_SCHED;
            PG8_LDB(B0, 1, 0); PG8_LDB(B1, 1, 1); PG8_SCHED; PG8_LDA(At, 1, 0); PG8_STAGE(PG8_SA(0, 1), a2 + hstepA, voffA);
            PG8_WAIT_V(8); PG8_WAIT_L(0); PG8_BAR; PG8_MMA(0, 0, At, B0); PG8_MMA(0, 1, At, B1); PG8_BAR; PG8_SCHED;
            PG8_LDA(At, 1, 1); PG8_STAGE(PG8_SB(1, 0), b3, voffB); PG8_STAGE(PG8_SB(1, 1), b3 + hstepB, voffB); PG8_STAGE(PG8_SA(1, 0), a3, voffA);
            PG8_WAIT_V(8); PG8_WAIT_L(0); PG8_BAR; PG8_MMA(1, 0, At, B0); PG8_MMA(1, 1, At, B1); PG8_BAR; PG8_SCHED;
        }
        if (wr == 0) PG8_BAR;
        if constexpr (!Epi::AFTER_DRAIN) E(acc, cur, wr, wc, fr, fq);
        if (!has_next) break;
#pragma unroll
        for (int a = 0; a < 2; ++a)
#pragma unroll
            for (int b = 0; b < 2; ++b)
#pragma unroll
                for (int m = 0; m < 4; ++m)
#pragma unroll
                    for (int n = 0; n < 2; ++n) acc[a][b][m][n] = (f32x4){0.f, 0.f, 0.f, 0.f};
        cur = nxt; cA = nA; cB = nB; ++ui;
        if (wr == 1) PG8_BAR;
    }
    PG8_WAIT_V(0);
    PG8_BAR;
    if constexpr (Epi::AFTER_DRAIN) E.fused(acc, cur, wr, wc, fr, fq, lds, tid);
#undef PG8_SA
#undef PG8_SB
#undef PG8_STAGE
#undef PG8_LDA
#undef PG8_LDB
#undef PG8_MMA
#undef PG8_WAIT_V
#undef PG8_WAIT_L
#undef PG8_BAR
#undef PG8_SCHED
}
}
using pg8::Unit;

typedef f32x4 AccT[2][2][4][2];

struct EpiInMain {
    static constexpr bool PERM = true, AFTER_DRAIN = false, NC = true;
    bf16_t* YC; bf16_t* XS; const u64* ssq; LAS unsigned char* lds;
    __device__ __forceinline__ void operator()(const AccT& acc, const Unit& u, int wr, int wc, int fr, int fq) const {
        const int rowb = u.pm * 256 + wr * 64 + fr;
        float rstd8[8];
        { u64 q8[8];
#pragma unroll
          for (int i = 0; i < 8; ++i) q8[i] = ssq[rowb + (i >> 2) * 128 + (i & 3) * 16];
#pragma unroll
          for (int i = 0; i < 8; ++i) rstd8[i] = rstd_of(q8[i]); }
        if (u.pn < 8) {
#pragma unroll
            for (int ai = 0; ai < 2; ++ai)
#pragma unroll
                for (int m = 0; m < 4; ++m) {
                    const int r = rowb + ai * 128 + m * 16;
                    const float rstd = rstd8[ai * 4 + m];
                    float o[8];
#pragma unroll
                    for (int n = 0; n < 2; ++n)
#pragma unroll
                        for (int j = 0; j < 4; ++j) {
                            const float uu = acc[ai][0][m][n][j] * rstd, zz = acc[ai][1][m][n][j] * rstd;
                            const float gu = uu * (1.0f + 0.044715f * uu * uu);
                            const float e1 = fexp2(gu * (-2.0f * 0.7978845608f * 1.4426950409f)), e2 = fexp2(zz * -1.4426950409f);
                            o[n * 4 + j] = (uu * zz) * frcp((1.0f + e1) * (1.0f + e2));
                        }
                    u32x4 w; w.x = cvt_pk_bf16(o[0], o[1]); w.y = cvt_pk_bf16(o[2], o[3]); w.z = cvt_pk_bf16(o[4], o[5]); w.w = cvt_pk_bf16(o[6], o[7]);
                    st16(YC + (size_t)r * 2048 + 128 * u.pn + 32 * wc + 8 * fq, w);
                }
        } else if (u.pn < 12) {
#pragma unroll
            for (int ai = 0; ai < 2; ++ai)
#pragma unroll
                for (int m = 0; m < 4; ++m) {
                    const int r = rowb + ai * 128 + m * 16;
                    const float rstd = rstd8[ai * 4 + m];
#pragma unroll
                    for (int bj = 0; bj < 2; ++bj) {
                        const int g = 16 * (u.pn - 8) + 4 * wc + 2 * bj + (fq >> 1);
                        const f32x4 v0 = acc[ai][bj][m][0] * rstd, v1 = acc[ai][bj][m][1] * rstd;
                        u32x4 w; w.x = cvt_pk_bf16(v0[0], v0[1]); w.y = cvt_pk_bf16(v0[2], v0[3]); w.z = cvt_pk_bf16(v1[0], v1[1]); w.w = cvt_pk_bf16(v1[2], v1[3]);
                        st16(XS + ((size_t)g * NCH + (r >> 5)) * XSK + (r & 31) * 16 + 8 * (fq & 1), w);
                    }
                }
        } else {
            LAS unsigned char* slab = lds + SLAB_OFF + (wr * 4 + wc) * SLAB_BYTES;
#pragma unroll
            for (int ai = 0; ai < 2; ++ai)
#pragma unroll
                for (int m = 0; m < 4; ++m) {
                    const float rstd = rstd8[ai * 4 + m];
                    u32x4 w[2];
#pragma unroll
                    for (int bj = 0; bj < 2; ++bj) {
                        float o[8];
#pragma unroll
                        for (int n = 0; n < 2; ++n)
#pragma unroll
                            for (int j = 0; j < 4; ++j) { const float zz = acc[ai][bj][m][n][j] * rstd; o[n * 4 + j] = zz * sigmoid_f(zz); }
                        w[bj].x = cvt_pk_bf16(o[0], o[1]); w[bj].y = cvt_pk_bf16(o[2], o[3]); w[bj].z = cvt_pk_bf16(o[4], o[5]); w[bj].w = cvt_pk_bf16(o[6], o[7]);
                    }
                    stage_store16(slab, fr, fq, w[0], w[1], YC + (size_t)(u.pm * 256 + wr * 64 + ai * 128 + m * 16) * 2048 + 1024 + 256 * (u.pn - 12) + 64 * wc, 2048);
                }
        }
    }
};

struct EpiInV {
    static constexpr bool PERM = true, AFTER_DRAIN = false, NC = true;
    bf16_t* GV; const u64* ssq; u64* vsum; u64* vsq; LAS unsigned char* lds;
    __device__ __forceinline__ void operator()(const AccT& acc, const Unit& u, int wr, int wc, int fr, int fq) const {
        f32x4 rs[2][2], s1[2][2], s2[2][2];
#pragma unroll
        for (int bj = 0; bj < 2; ++bj)
#pragma unroll
            for (int n = 0; n < 2; ++n) {
#pragma unroll
                for (int j = 0; j < 4; ++j) rs[bj][n][j] = rstd_of(ssq[u.pn * 256 + 64 * wc + 32 * bj + 8 * fq + 4 * n + j]);
                s1[bj][n] = (f32x4){0.f, 0.f, 0.f, 0.f}; s2[bj][n] = (f32x4){0.f, 0.f, 0.f, 0.f};
            }
        LAS unsigned char* slab = lds + SLAB_OFF + (wr * 4 + wc) * SLAB_BYTES;
#pragma unroll
        for (int ai = 0; ai < 2; ++ai)
#pragma unroll
            for (int m = 0; m < 4; ++m) {
                u32x4 w[2];
#pragma unroll
                for (int bj = 0; bj < 2; ++bj) {
                    f32x4 v[2];
#pragma unroll
                    for (int n = 0; n < 2; ++n) {
#pragma unroll
                        for (int j = 0; j < 4; ++j) v[n][j] = gelu_t(acc[ai][bj][m][n][j] * rs[bj][n][j]);
                        s1[bj][n] += v[n]; s2[bj][n] += v[n] * v[n];
                    }
                    w[bj].x = cvt_pk_bf16(v[0][0], v[0][1]); w[bj].y = cvt_pk_bf16(v[0][2], v[0][3]); w[bj].z = cvt_pk_bf16(v[1][0], v[1][1]); w[bj].w = cvt_pk_bf16(v[1][2], v[1][3]);
                }
                stage_store16(slab, fr, fq, w[0], w[1], GV + (size_t)(u.pm * 256 + ai * 128 + wr * 64 + m * 16) * TP + u.pn * 256 + 64 * wc, TP);
            }
        float v1[16], v2[16];
#pragma unroll
        for (int i = 0; i < 16; ++i) { v1[i] = s1[i >> 3][(i >> 2) & 1][i & 3]; v2[i] = s2[i >> 3][(i >> 2) & 1][i & 3]; }
#define RS_STEP(K) { const bool up = (fr & (K)) != 0; _Pragma("unroll") for (int i = 0; i < (K); ++i) { \
            const float k1 = up ? v1[i + (K)] : v1[i], g1 = up ? v1[i] : v1[i + (K)], k2 = up ? v2[i + (K)] : v2[i], g2 = up ? v2[i] : v2[i + (K)]; \
            v1[i] = k1 + __shfl_xor(g1, (K)); v2[i] = k2 + __shfl_xor(g2, (K)); } }
        RS_STEP(8) RS_STEP(4) RS_STEP(2) RS_STEP(1)
#undef RS_STEP
        { const int t = u.pn * 256 + 64 * wc + 32 * (fr >> 3) + 8 * fq + 4 * ((fr >> 2) & 1) + (fr & 3); atomicAdd(vsum + t, to_fx(v1[0], FX_V)); atomicAdd(vsq + t, to_fx(v2[0], FX_V)); }
    }
};

template <int ACT> struct EpiBf16 {
    static constexpr bool PERM = true, AFTER_DRAIN = false, NC = true;
    bf16_t* O; int ldc; size_t gstride; LAS unsigned char* lds;
    __device__ __forceinline__ void operator()(const AccT& acc, const Unit& u, int wr, int wc, int fr, int fq) const {
        bf16_t* base = O + (size_t)u.g * gstride + (size_t)(u.pm * 256 + wr * 64) * ldc + u.pn * 256 + 64 * wc;
        LAS unsigned char* slab = lds + SLAB_OFF + (wr * 4 + wc) * SLAB_BYTES;
#pragma unroll
        for (int ai = 0; ai < 2; ++ai)
#pragma unroll
            for (int m = 0; m < 4; ++m) {
                u32x4 w[2];
#pragma unroll
                for (int bj = 0; bj < 2; ++bj) {
                    f32x4 v0 = acc[ai][bj][m][0], v1 = acc[ai][bj][m][1];
                    if (ACT == 1) {
#pragma unroll
                        for (int j = 0; j < 4; ++j) { v0[j] = gelu_t(v0[j]); v1[j] = gelu_t(v1[j]); }
                    }
                    w[bj].x = cvt_pk_bf16(v0[0], v0[1]); w[bj].y = cvt_pk_bf16(v0[2], v0[3]); w[bj].z = cvt_pk_bf16(v1[0], v1[1]); w[bj].w = cvt_pk_bf16(v1[2], v1[3]);
                }
                stage_store16(slab, fr, fq, w[0], w[1], base + (size_t)(ai * 128 + m * 16) * ldc, (size_t)ldc);
            }
    }
};

struct EpiS1Scan {
    static constexpr bool PERM = true, AFTER_DRAIN = true, NC = false;
    bf16_t* XS; const float* AQ;
    __device__ __forceinline__ void fused(const AccT& acc, const Unit& u, int wr, int wc, int fr, int fq, LAS unsigned char* lds, int tid) const {
        LAS float* S = (LAS float*)lds;
        LAS f32x2* EE = (LAS f32x2*)(lds + 256 * 132 * 4);
        const int cps = u.pm < (TPROMPT / QC / 256) ? 64 : 128;
        const int p = tid & 63, seg = tid >> 6, nsps = cps >> 5, sidx = seg & (nsps - 1), seg0 = seg - sidx;
#pragma unroll
        for (int dir = 0; dir < 2; ++dir) {
#pragma unroll
            for (int ai = 0; ai < 2; ++ai)
#pragma unroll
                for (int m = 0; m < 4; ++m)
#pragma unroll
                    for (int n = 0; n < 2; ++n) *(LAS f32x4*)(S + (128 * ai + 64 * wr + 16 * m + fr) * 132 + 32 * wc + 8 * fq + 4 * n) = acc[ai][dir][m][n];
            asm volatile("s_waitcnt lgkmcnt(0)" ::: "memory"); __builtin_amdgcn_s_barrier(); asm volatile("" ::: "memory");
            const float ar = AQ[((u.g * 2 + dir) * 64 + p) * 2], ai_ = AQ[((u.g * 2 + dir) * 64 + p) * 2 + 1];
            float lr[32], li[32];
#pragma unroll
            for (int i = 0; i < 32; ++i) { const int cix = 32 * seg + (dir ? 31 - i : i); lr[i] = S[cix * 132 + p]; li[i] = S[cix * 132 + 64 + p]; }
            float er = 0.f, ei = 0.f;
#pragma unroll
            for (int i = 0; i < 32; ++i) { const float nr = ar * er - ai_ * ei + lr[i], ni = ar * ei + ai_ * er + li[i]; er = nr; ei = ni; }
            EE[seg * 64 + p] = (f32x2){er, ei};
            float br = ar, bi = ai_;
#pragma unroll
            for (int k = 0; k < 5; ++k) { const float nr = br * br - bi * bi, ni = 2.f * br * bi; br = nr; bi = ni; }
            asm volatile("s_waitcnt lgkmcnt(0)" ::: "memory"); __builtin_amdgcn_s_barrier(); asm volatile("" ::: "memory");
            float sr = 0.f, si = 0.f;
            const int nprev = dir ? (nsps - 1 - sidx) : sidx;
            for (int k = 0; k < nprev; ++k) { const int s2 = dir ? (seg0 + nsps - 1 - k) : (seg0 + k); const f32x2 e = EE[s2 * 64 + p];
                const float nr = br * sr - bi * si + e.x, ni = br * si + bi * sr + e.y; sr = nr; si = ni; }
            unsigned* xp = (unsigned*)(XS + ((size_t)u.g * NCH + (size_t)u.pm * 256 + 32 * seg) * XSK + 512 + dir * 128) + p;
#pragma unroll
            for (int i = 0; i < 32; ++i) { const int cl = dir ? 31 - i : i;
                xp[(size_t)cl * (XSK / 2)] = cvt_pk_bf16(sr, si);
                const float nr = ar * sr - ai_ * si + lr[i], ni = ar * si + ai_ * sr + li[i]; sr = nr; si = ni; }
            asm volatile("s_waitcnt lgkmcnt(0)" ::: "memory"); __builtin_amdgcn_s_barrier(); asm volatile("" ::: "memory");
        }
    }
};

struct EpiGlu {
    static constexpr bool PERM = true, AFTER_DRAIN = false, NC = true;
    const bf16_t* GY; bf16_t* YC; const float* bglu; LAS unsigned char* lds;
    __device__ __forceinline__ void operator()(const AccT& acc, const Unit& u, int wr, int wc, int fr, int fq) const {
        const int rowb = u.pm * 256 + wr * 64 + fr, cw = u.pn * 256 + 64 * wc;
        LAS unsigned char* slab = lds + SLAB_OFF + (wr * 4 + wc) * SLAB_BYTES;
        f32x4 bb[2][2];
#pragma unroll
        for (int bj = 0; bj < 2; ++bj) { bb[bj][0] = *(const f32x4*)(bglu + cw + 32 * bj + 8 * fq); bb[bj][1] = *(const f32x4*)(bglu + cw + 32 * bj + 8 * fq + 4); }
#pragma unroll
        for (int ai = 0; ai < 2; ++ai)
#pragma unroll
            for (int mp = 0; mp < 2; ++mp) {
                u32x4 gy[2][2], sz[2][2];
#pragma unroll
                for (int mm = 0; mm < 2; ++mm)
#pragma unroll
                    for (int bj = 0; bj < 2; ++bj) { const int r = rowb + ai * 128 + (2 * mp + mm) * 16, c0 = cw + 32 * bj + 8 * fq;
                        gy[mm][bj] = *(const u32x4*)(GY + ((size_t)(c0 >> 4) * TP + r) * 16 + (c0 & 15));
                        sz[mm][bj] = *(const u32x4*)(YC + (size_t)r * 2048 + 1024 + c0); }
                asm volatile("" ::: "memory");
#pragma unroll
                for (int mm = 0; mm < 2; ++mm) { const int m = 2 * mp + mm;
                    u32x4 w[2];
#pragma unroll
                    for (int bj = 0; bj < 2; ++bj) {
                        const f32x4 a0 = acc[ai][bj][m][0] + bb[bj][0], a1 = acc[ai][bj][m][1] + bb[bj][1]; const u32x4 g = gy[mm][bj], s = sz[mm][bj];
                        float o[8];
                        o[0] = bf_lo(g.x) * sigmoid_f(a0[0]) * bf_lo(s.x); o[1] = bf_hi(g.x) * sigmoid_f(a0[1]) * bf_hi(s.x);
                        o[2] = bf_lo(g.y) * sigmoid_f(a0[2]) * bf_lo(s.y); o[3] = bf_hi(g.y) * sigmoid_f(a0[3]) * bf_hi(s.y);
                        o[4] = bf_lo(g.z) * sigmoid_f(a1[0]) * bf_lo(s.z); o[5] = bf_hi(g.z) * sigmoid_f(a1[1]) * bf_hi(s.z);
                        o[6] = bf_lo(g.w) * sigmoid_f(a1[2]) * bf_lo(s.w); o[7] = bf_hi(g.w) * sigmoid_f(a1[3]) * bf_hi(s.w);
                        w[bj].x = cvt_pk_bf16(o[0], o[1]); w[bj].y = cvt_pk_bf16(o[2], o[3]); w[bj].z = cvt_pk_bf16(o[4], o[5]); w[bj].w = cvt_pk_bf16(o[6], o[7]);
                    }
                    stage_store16(slab, fr, fq, w[0], w[1], YC + (size_t)(u.pm * 256 + wr * 64 + ai * 128 + m * 16) * 2048 + 1024 + cw, 2048);
                }
                asm volatile("" ::: "memory");
            }
    }
};

struct EpiOut {
    static constexpr bool PERM = true, AFTER_DRAIN = false, NC = true;
    const float* xp; const float* xs; bf16_t* XB; u64* ssq_next; float* xf; LAS unsigned char* lds;
    __device__ __forceinline__ float sq8(const f32x4& y0, const f32x4& y1) const { return (y0[0] * y0[0] + y0[1] * y0[1]) + (y0[2] * y0[2] + y0[3] * y0[3]) + (y1[0] * y1[0] + y1[1] * y1[1]) + (y1[2] * y1[2] + y1[3] * y1[3]); }
    __device__ __forceinline__ void operator()(const AccT& acc, const Unit& u, int wr, int wc, int fr, int fq) const {
        const int rowb = u.pm * 256 + wr * 64 + fr, cw = u.pn * 256 + 64 * wc;
        LAS unsigned char* slab = lds + SLAB_OFF + (wr * 4 + wc) * SLAB_BYTES;
        float q[8];
#pragma unroll
        for (int i = 0; i < 8; ++i) q[i] = 0.f;
#pragma unroll
        for (int ai = 0; ai < 2; ++ai)
#pragma unroll
            for (int mp = 0; mp < 2; ++mp) {
                f32x4 x0[2][2], x1[2][2];
                if (xp) {
#pragma unroll
                    for (int mm = 0; mm < 2; ++mm)
#pragma unroll
                        for (int bj = 0; bj < 2; ++bj) { const int r = rowb + ai * 128 + (2 * mp + mm) * 16;
                            const float* b = (r < TPROMPT ? xp + (size_t)r * 1024 : xs + (size_t)(r - TPROMPT) * 1024) + cw + 32 * bj + 8 * fq; x0[mm][bj] = *(const f32x4*)b; x1[mm][bj] = *(const f32x4*)(b + 4); }
                } else {
                    u32x4 raw[2][2];
#pragma unroll
                    for (int mm = 0; mm < 2; ++mm)
#pragma unroll
                        for (int bj = 0; bj < 2; ++bj) raw[mm][bj] = *(const u32x4*)(XB + (size_t)(rowb + ai * 128 + (2 * mp + mm) * 16) * 1024 + cw + 32 * bj + 8 * fq);
#pragma unroll
                    for (int mm = 0; mm < 2; ++mm)
#pragma unroll
                        for (int bj = 0; bj < 2; ++bj) { const u32x4 w = raw[mm][bj];
                            x0[mm][bj] = (f32x4){bf_lo(w.x), bf_hi(w.x), bf_lo(w.y), bf_hi(w.y)}; x1[mm][bj] = (f32x4){bf_lo(w.z), bf_hi(w.z), bf_lo(w.w), bf_hi(w.w)}; }
                }
                asm volatile("" ::: "memory");
#pragma unroll
                for (int mm = 0; mm < 2; ++mm) { const int m = 2 * mp + mm;
                    const f32x4 y00 = x0[mm][0] + acc[ai][0][m][0], y01 = x1[mm][0] + acc[ai][0][m][1], y10 = x0[mm][1] + acc[ai][1][m][0], y11 = x1[mm][1] + acc[ai][1][m][1];
                    q[ai * 4 + m] = sq8(y00, y01) + sq8(y10, y11);
                    if (xf) { float* d = xf + (size_t)(rowb + ai * 128 + m * 16) * 1024 + cw + 8 * fq; *(f32x4*)d = y00; *(f32x4*)(d + 4) = y01; *(f32x4*)(d + 32) = y10; *(f32x4*)(d + 36) = y11; }
                    else { u32x4 w0, w1; w0.x = cvt_pk_bf16(y00[0], y00[1]); w0.y = cvt_pk_bf16(y00[2], y00[3]); w0.z = cvt_pk_bf16(y01[0], y01[1]); w0.w = cvt_pk_bf16(y01[2], y01[3]);
                        w1.x = cvt_pk_bf16(y10[0], y10[1]); w1.y = cvt_pk_bf16(y10[2], y10[3]); w1.z = cvt_pk_bf16(y11[0], y11[1]); w1.w = cvt_pk_bf16(y11[2], y11[3]);
                        stage_store16(slab, fr, fq, w0, w1, XB + (size_t)(u.pm * 256 + wr * 64 + ai * 128 + m * 16) * 1024 + cw, 1024); }
                }
                asm volatile("" ::: "memory");
            }
#pragma unroll
        for (int i = 0; i < 8; ++i) { const int r = rowb + (i >> 2) * 128 + (i & 3) * 16;
            float t = q[i]; t += __shfl_xor(t, 16); t += __shfl_xor(t, 32);
            if (fq == 0) atomicAdd(ssq_next + r, to_fx(t, FX_SSQ)); }
    }
};

struct Params { const float* in[20]; float* out; unsigned char* ws; int lo, hi; };
enum { I_XP = 0, I_XS, I_NORMG, I_WIN, I_LNG, I_LNB, I_WS, I_BS, I_LAMRE, I_LAMIM, I_LOGDT, I_BRE, I_BIM, I_CRE, I_CIM, I_DSKIP, I_WGLU, I_BGLU, I_WOUT, I_FINALG };

__device__ __forceinline__ void transpose_item(const float* W, int N, int k0, int n0, const float* scale, bf16_t* dst, int Kdst, LAS float* scr, int lane) {
    float tv[32];
#pragma unroll
    for (int i = 0; i < 32; ++i) tv[i] = W[(size_t)(k0 + 2 * i + (lane >> 5)) * N + n0 + (lane & 31)];
    if (scale) {
#pragma unroll
        for (int i = 0; i < 32; ++i) tv[i] *= scale[k0 + 2 * i + (lane >> 5)]; }
#pragma unroll
    for (int i = 0; i < 32; ++i) scr[(2 * i + (lane >> 5)) * 33 + (lane & 31)] = tv[i];
    asm volatile("s_waitcnt lgkmcnt(0)" ::: "memory");
    const int c = lane & 7;
#pragma unroll
    for (int j = 0; j < 4; ++j) { const int n = (lane >> 3) + 8 * j; const LAS float* s = scr + (8 * c) * 33 + n;
        u32x4 o; o.x = cvt_pk_bf16(s[0 * 33], s[1 * 33]); o.y = cvt_pk_bf16(s[2 * 33], s[3 * 33]); o.z = cvt_pk_bf16(s[4 * 33], s[5 * 33]); o.w = cvt_pk_bf16(s[6 * 33], s[7 * 33]);
        *(u32x4*)(dst + (size_t)n * Kdst + k0 + 8 * c) = o; }
    asm volatile("s_waitcnt lgkmcnt(0)" ::: "memory");
}

__device__ __forceinline__ void pre_phase(const Params& P, LAS unsigned char* lds, int tid, int lane, int wave) {
    unsigned char* ws = P.ws;
    {
        LAS float* scr = (LAS float*)(lds + wave * 8448);
        const int gw = blockIdx.x * 8 + wave, NGW = gridDim.x * 8;
        for (int it = gw; it < DEPTH * 4096; it += NGW) {
            const int l = it >> 12; int r = it & 4095;
            if (r < 2560) {
                const int kb = r / 160, nb = r % 160, sg = nb >> 5, b = nb & 31;
                int row;
                if (sg == 0) row = 256 * (b >> 2) + 64 * (b & 3);
                else if (sg == 1) row = 4096 + 32 * b;
                else if (sg == 2) row = 256 * (b >> 2) + 64 * (b & 3) + 32;
                else if (sg == 3) row = 2048 + 32 * b;
                else row = 3072 + 32 * b;
                transpose_item(P.in[I_WIN] + (size_t)l * 1024 * NIN, NIN, 64 * kb, 32 * nb, P.in[I_NORMG] + l * 1024,
                               (bf16_t*)(ws + WS_WIN) + ((size_t)l * NIN + row) * 1024, 1024, scr, lane);
            } else if (r < 3072) {
                r -= 2560; const int kb = r >> 5, nb = r & 31;
                transpose_item(P.in[I_WGLU] + (size_t)l * 1024 * 1024, 1024, 64 * kb, 32 * nb, nullptr,
                               (bf16_t*)(ws + WS_WGLU) + ((size_t)l * 1024 + 32 * nb) * 1024, 1024, scr, lane);
            } else {
                r -= 3072; const int kb = r >> 5, nb = r & 31;
                transpose_item(P.in[I_WOUT] + (size_t)l * 2048 * 1024, 1024, 64 * kb, 32 * nb, nullptr,
                               (bf16_t*)(ws + WS_WOUT) + ((size_t)l * 1024 + 32 * nb) * 2048, 2048, scr, lane);
            }
        }
    }
    {
        const float* src = P.in[I_WS]; bf16_t* dst = (bf16_t*)(ws + WS_WSB);
        for (int i = (blockIdx.x * NTHR + tid) * 8; i < DEPTH * 4 * 128 * 128; i += gridDim.x * NTHR * 8) {
            const f32x4 a = *(const f32x4*)(src + i), b = *(const f32x4*)(src + i + 4);
            u32x4 w; w.x = cvt_pk_bf16(a[0], a[1]); w.y = cvt_pk_bf16(a[2], a[3]); w.z = cvt_pk_bf16(b[0], b[1]); w.w = cvt_pk_bf16(b[2], b[3]);
            *(u32x4*)(dst + i) = w;
        }
    }
    {
        float* vec = (float*)(ws + WS_VEC);
        for (int i = blockIdx.x * NTHR + tid; i < VEC_N; i += gridDim.x * NTHR) {
            float v;
            if (i < VEC_LNB) v = P.in[I_LNG][i]; else if (i < VEC_BGLU) v = P.in[I_LNB][i - VEC_LNB]; else if (i < VEC_BS) v = P.in[I_BGLU][i - VEC_BGLU];
            else if (i < VEC_FG) v = P.in[I_BS][i - VEC_BS]; else v = P.in[I_FINALG][i - VEC_FG];
            vec[i] = v;
        }
    }
    __syncthreads();
    LAS f32x2* PW = (LAS f32x2*)lds;
    LAS f32x2* BB = (LAS f32x2*)(lds + 33792);
    LAS f32x2* CT = (LAS f32x2*)(lds + 33792 + 16384);
    LAS float* KT = (LAS float*)(lds + 33792 + 32768);
    LAS f32x2* FF = (LAS f32x2*)(lds + 33792 + 32768 + 65536);
    LAS float* DS = (LAS float*)(lds + 33792 + 32768 + 65536 + 1024);
    for (int lg = blockIdx.x; lg < DEPTH * 64; lg += gridDim.x) {
        const int l = lg >> 6, g = lg & 63;
        if (tid < 128) {
            const int p = tid & 63, dir = tid >> 6, ig = (l * 2 + dir) * 64 + g;
            const double dt = exp((double)P.in[I_LOGDT][ig]);
            const double lre = (double)P.in[I_LAMRE][ig * 64 + p], lim = (double)P.in[I_LAMIM][ig * 64 + p];
            const double mag = exp(lre * dt); double sn, cs; sincos(lim * dt, &sn, &cs);
            const double ar = mag * cs, ai = mag * sn;
            double zr = 1.0, zi = 0.0;
            for (int k = 0; k <= QC; ++k) { PW[(dir * 33 + k) * 64 + p] = (f32x2){(float)zr, (float)zi}; const double nr = zr * ar - zi * ai, ni = zr * ai + zi * ar; zr = nr; zi = ni; }
            const double nr = ar - 1.0, ni = ai, den = lre * lre + lim * lim;
            FF[dir * 64 + p] = (f32x2){(float)((nr * lre + ni * lim) / den), (float)((ni * lre - nr * lim) / den)};
        }
        for (int it = tid; it < 2 * 64 * 16; it += NTHR) {
            const int ch = it & 15, p = (it >> 4) & 63, dir = it >> 10;
            const size_t ci = ((size_t)((l * 2 + dir) * 64 + g) * 16 + ch) * 64 + p;
            CT[(dir * 64 + p) * 16 + ch] = (f32x2){P.in[I_CRE][ci], P.in[I_CIM][ci]};
        }
        if (tid < 16) DS[tid] = P.in[I_DSKIP][l * 1024 + g * 16 + tid];
        __syncthreads();
        for (int it = tid; it < 2 * 64 * 16; it += NTHR) {
            const int c = it & 15, p = (it >> 4) & 63, dir = it >> 10;
            const size_t bi = ((size_t)((l * 2 + dir) * 64 + g) * 64 + p) * 16 + c;
            const float br = P.in[I_BRE][bi], bm = P.in[I_BIM][bi]; const f32x2 f = FF[dir * 64 + p];
            BB[(dir * 64 + p) * 16 + c] = (f32x2){f.x * br - f.y * bm, f.x * bm + f.y * br};
        }
        __syncthreads();
        for (int it = tid; it < 2 * 32 * 16; it += NTHR) {
            const int ch = it & 15, lag = (it >> 4) & 31, dir = it >> 9;
            float a[16];
#pragma unroll
            for (int j = 0; j < 16; ++j) a[j] = 0.f;
            for (int p = 0; p < 64; ++p) {
                const f32x2 c = CT[(dir * 64 + p) * 16 + ch], w = PW[(dir * 33 + lag) * 64 + p];
                const float xr = c.x * w.x - c.y * w.y, xi = c.x * w.y + c.y * w.x;
                const LAS f32x4* bp = (const LAS f32x4*)(BB + (dir * 64 + p) * 16);
#pragma unroll
                for (int j = 0; j < 8; ++j) { const f32x4 b = bp[j]; a[2 * j] += xr * b[0] - xi * b[1]; a[2 * j + 1] += xr * b[2] - xi * b[3]; }
            }
            LAS f32x4* kp = (LAS f32x4*)(KT + ((dir * 32 + lag) * 16 + ch) * 16);
#pragma unroll
            for (int j = 0; j < 4; ++j) kp[j] = (f32x4){a[4 * j], a[4 * j + 1], a[4 * j + 2], a[4 * j + 3]};
        }
        __syncthreads();
        {
            bf16_t* W3 = (bf16_t*)(ws + WS_W3) + (size_t)lg * 512 * XSK;
            for (int it = tid; it < 512 * 96; it += NTHR) {
                const int kc = it % 96, n = it / 96, t = n >> 4, ch = n & 15, k0 = kc * 8;
                float v[8];
                if (k0 < 512) {
                    const int s = k0 >> 4, c0 = k0 & 15;
#pragma unroll
                    for (int j = 0; j < 8; ++j) {
                        float x = 0.f;
                        if (s <= t) x += KT[((0 * 32 + (t - s)) * 16 + ch) * 16 + c0 + j];
                        if (s >= t) x += KT[((1 * 32 + (s - t)) * 16 + ch) * 16 + c0 + j];
                        if (s == t && ch == c0 + j) x += DS[ch];
                        v[j] = x;
                    }
                } else {
                    const int q = k0 - 512, dir = q >> 7, p0 = (q & 127) >> 1, e = dir == 0 ? t + 1 : QC - t;
#pragma unroll
                    for (int j = 0; j < 8; ++j) {
                        const f32x2 c = CT[(dir * 64 + p0 + (j >> 1)) * 16 + ch], w = PW[(dir * 33 + e) * 64 + p0 + (j >> 1)];
                        v[j] = (j & 1) == 0 ? (c.x * w.x - c.y * w.y) : -(c.x * w.y + c.y * w.x);
                    }
                }
                u32x4 o; o.x = cvt_pk_bf16(v[0], v[1]); o.y = cvt_pk_bf16(v[2], v[3]); o.z = cvt_pk_bf16(v[4], v[5]); o.w = cvt_pk_bf16(v[6], v[7]);
                *(u32x4*)(W3 + (size_t)n * XSK + k0) = o;
            }
        }
        {
            bf16_t* W1 = (bf16_t*)(ws + WS_W1) + (size_t)lg * 256 * 512;
            for (int it = tid; it < 256 * 64; it += NTHR) {
                const int kc = it & 63, n = it >> 6, k0 = kc * 8, s = k0 >> 4, c0 = k0 & 15, dir = n >> 7, ri = (n >> 6) & 1, p = n & 63, e = dir == 0 ? (QC - 1 - s) : s;
                const f32x2 w = PW[(dir * 33 + e) * 64 + p];
                float v[8];
#pragma unroll
                for (int j = 0; j < 8; ++j) { const f32x2 b = BB[(dir * 64 + p) * 16 + c0 + j]; v[j] = ri == 0 ? (w.x * b.x - w.y * b.y) : (w.x * b.y + w.y * b.x); }
                u32x4 o; o.x = cvt_pk_bf16(v[0], v[1]); o.y = cvt_pk_bf16(v[2], v[3]); o.z = cvt_pk_bf16(v[4], v[5]); o.w = cvt_pk_bf16(v[6], v[7]);
                *(u32x4*)(W1 + (size_t)n * 512 + k0) = o;
            }
        }
        if (tid < 128) { const int dir = tid >> 6, p = tid & 63; const f32x2 w = PW[(dir * 33 + QC) * 64 + p];
            float* aq = (float*)(ws + WS_AQ) + ((size_t)(lg * 2 + dir) * 64 + p) * 2; aq[0] = w.x; aq[1] = w.y; }
        __syncthreads();
    }
}

__device__ __forceinline__ void p0_phase(const Params& P, int wv) {
    const int tid = opaque_tid(wv), lane = tid & 63, wave = __builtin_amdgcn_readfirstlane(tid >> 6), bid = opaque_bid();
    bf16_t* XB = (bf16_t*)(P.ws + WS_XB); u64* ssq = (u64*)(P.ws + WS_SSQ);
    for (int r = bid * 8 + wave; r < TP; r += gridDim.x * 8) {
        const float* src = r < TPROMPT ? P.in[I_XP] + (size_t)r * 1024 : P.in[I_XS] + (size_t)(r - TPROMPT) * 1024;
        const f32x4* xr = (const f32x4*)src + lane; u32x2* o = (u32x2*)(XB + (size_t)r * 1024) + lane;
        float s = 0.f;
#pragma unroll
        for (int j = 0; j < 4; ++j) { const f32x4 v = xr[64 * j]; s += (v[0] * v[0] + v[1] * v[1]) + (v[2] * v[2] + v[3] * v[3]); o[64 * j] = (u32x2){cvt_pk_bf16(v[0], v[1]), cvt_pk_bf16(v[2], v[3])}; }
        s = wave_sum(s);
        if (lane == 0) ssq[r] = to_fx(s, FX_SSQ);
    }
}
__device__ __forceinline__ void pz_phase(const Params& P, int wv) {
    const int tid = opaque_tid(wv), lane = tid & 63, wave = __builtin_amdgcn_readfirstlane(tid >> 6), bid = opaque_bid();
    const float* XF = (const float*)(P.ws + WS_XF); const u64* ssq = (const u64*)(P.ws + WS_SSQ) + (size_t)DEPTH * TP;
    const f32x4* fg = (const f32x4*)((const float*)(P.ws + WS_VEC) + VEC_FG) + lane;
    for (int r = bid * 8 + wave; r < TP; r += gridDim.x * 8) {
        const f32x4* xr = (const f32x4*)(XF + (size_t)r * 1024) + lane; f32x4* o = (f32x4*)(P.out + (size_t)r * 1024) + lane;
        const float rstd = rstd_of(ssq[r]);
#pragma unroll
        for (int j = 0; j < 4; ++j) o[64 * j] = xr[64 * j] * rstd * fg[64 * j];
    }
}

__device__ __forceinline__ void spatial_phase(unsigned char* ws, bf16_t* YC, LAS unsigned char* lds, int layer, int wv) {
    const int tid = opaque_tid(wv);
    const int wave = __builtin_amdgcn_readfirstlane(tid >> 6), lane = tid & 63, fr = lane & 15, fq = lane >> 4;
    const int c = opaque_bid(), h = c & 3, wj = wave >> 1, wp = wave & 1;
    const bf16_t* GV = (const bf16_t*)(ws + WS_GV);
    const u64* vsum = (const u64*)(ws + WS_VSUM) + (size_t)layer * TP;
    const u64* vsq = (const u64*)(ws + WS_VSQ) + (size_t)layer * TP;
    const float* vec = (const float*)(ws + WS_VEC);
    const float* lng = vec + VEC_LNG + layer * 1024; const float* lnb = vec + VEC_LNB + layer * 1024; const float* bs = vec + VEC_BS + (layer * 4 + h) * 128;
    LAS unsigned char* WsL = lds; LAS unsigned char* GvL = lds + 34816;
    const int ch = tid & 15, r0 = tid >> 4;
    {
        const bf16_t* src = (const bf16_t*)(ws + WS_WSB) + (size_t)(layer * 4 + h) * 128 * 128;
#pragma unroll
        for (int i = 0; i < 4; ++i) { const int r = r0 + 32 * i; *(LAS u32x4*)(WsL + r * 272 + ch * 16) = *(const u32x4*)(src + r * 128 + ch * 8); }
    }
    float lg[8], lb[8];
#pragma unroll
    for (int ii = 0; ii < 8; ++ii) { lg[ii] = lng[256 * h + r0 + 32 * ii]; lb[ii] = lnb[256 * h + r0 + 32 * ii]; }
    float bsv[4];
#pragma unroll
    for (int pt = 0; pt < 4; ++pt) bsv[pt] = bs[64 * wp + 16 * pt + fr];
    const int cstride = (int)(gridDim.x >> 2), nchunks = TP / 128;
    LAS f32x2* ST = (LAS f32x2*)(lds + 34816 + 69632);
    for (int i = tid; i < ((nchunks - (c >> 2) + cstride - 1) / cstride) * 128; i += NTHR) {
        const int t = ((c >> 2) + (i >> 7) * cstride) * 128 + (i & 127);
        const float m = from_fx(vsum[t], (1.0f / FX_V) * (1.0f / 1024.0f)), q = from_fx(vsq[t], (1.0f / FX_V) * (1.0f / 1024.0f));
        ST[i] = (f32x2){m, rsqrtf(fmaxf(q - m * m, 0.f) + EPS)};
    }
    u32x4 raw[8];
#define SP_LOAD(CI) do { const int _t0 = (CI) * 128; _Pragma("unroll") for (int ii = 0; ii < 8; ++ii) raw[ii] = *(const u32x4*)(GV + (size_t)(256 * h + r0 + 32 * ii) * TP + _t0 + ch * 8); } while (0)
    int cidx = c >> 2, ui = 0;
    if (cidx < nchunks) SP_LOAD(cidx);
    for (; cidx < nchunks; cidx += cstride, ++ui) {
        const int t0 = cidx * 128;
        __syncthreads();
        float mu[8], rs[8];
#pragma unroll
        for (int k = 0; k < 8; ++k) { const f32x2 s = ST[ui * 128 + ch * 8 + k]; mu[k] = s.x; rs[k] = s.y; }
#pragma unroll
        for (int ii = 0; ii < 8; ++ii) {
            const int j = r0 + 32 * ii; const u32x4 w0 = raw[ii]; const float g = lg[ii], b = lb[ii];
            float y[8];
            y[0] = (bf_lo(w0.x) - mu[0]) * rs[0] * g + b; y[1] = (bf_hi(w0.x) - mu[1]) * rs[1] * g + b;
            y[2] = (bf_lo(w0.y) - mu[2]) * rs[2] * g + b; y[3] = (bf_hi(w0.y) - mu[3]) * rs[3] * g + b;
            y[4] = (bf_lo(w0.z) - mu[4]) * rs[4] * g + b; y[5] = (bf_hi(w0.z) - mu[5]) * rs[5] * g + b;
            y[6] = (bf_lo(w0.w) - mu[6]) * rs[6] * g + b; y[7] = (bf_hi(w0.w) - mu[7]) * rs[7] * g + b;
            u32x4 w; w.x = cvt_pk_bf16(y[0], y[1]); w.y = cvt_pk_bf16(y[2], y[3]); w.z = cvt_pk_bf16(y[4], y[5]); w.w = cvt_pk_bf16(y[6], y[7]);
            *(LAS u32x4*)(GvL + j * 272 + ch * 16) = w;
        }
        __syncthreads();
        if (cidx + cstride < nchunks) SP_LOAD(cidx + cstride);
        u32x4 p1[4][2];
#pragma unroll
        for (int pt = 0; pt < 4; ++pt)
#pragma unroll
            for (int u2 = 0; u2 < 2; ++u2) p1[pt][u2] = *(const u32x4*)(YC + (size_t)(t0 + 64 * wp + 16 * pt + fr) * 2048 + 256 * h + 64 * wj + 32 * u2 + 8 * fq);
        asm volatile("" ::: "memory");
        f32x4 acc[2][2][4];
#pragma unroll
        for (int a = 0; a < 2; ++a)
#pragma unroll
            for (int n = 0; n < 2; ++n)
#pragma unroll
                for (int pt = 0; pt < 4; ++pt) acc[a][n][pt] = (f32x4){0.f, 0.f, 0.f, 0.f};
#pragma unroll
        for (int ks = 0; ks < 4; ++ks) {
            bf16x8 av[2][2], bv[4];
#pragma unroll
            for (int u2 = 0; u2 < 2; ++u2)
#pragma unroll
                for (int n = 0; n < 2; ++n) { const int j = 64 * wj + 32 * u2 + 8 * (fr >> 2) + 4 * n + (fr & 3); av[u2][n] = *(const LAS bf16x8*)(GvL + j * 272 + ks * 64 + fq * 16); }
#pragma unroll
            for (int pt = 0; pt < 4; ++pt) { const int p = 64 * wp + 16 * pt + fr; bv[pt] = *(const LAS bf16x8*)(WsL + p * 272 + ks * 64 + fq * 16); }
#pragma unroll
            for (int u2 = 0; u2 < 2; ++u2)
#pragma unroll
                for (int n = 0; n < 2; ++n)
#pragma unroll
                    for (int pt = 0; pt < 4; ++pt) acc[u2][n][pt] = __builtin_amdgcn_mfma_f32_16x16x32_bf16(av[u2][n], bv[pt], acc[u2][n][pt], 0, 0, 0);
        }
#pragma unroll
        for (int pt = 0; pt < 4; ++pt) {
#pragma unroll
            for (int u2 = 0; u2 < 2; ++u2) {
                bf16_t* yp = YC + (size_t)(t0 + 64 * wp + 16 * pt + fr) * 2048 + 256 * h + 64 * wj + 32 * u2 + 8 * fq;
                const u32x4 pv = p1[pt][u2];
                const f32x4 d0 = acc[u2][0][pt] + bsv[pt], d1 = acc[u2][1][pt] + bsv[pt];
                u32x4 w;
                w.x = cvt_pk_bf16(bf_lo(pv.x) * d0[0], bf_hi(pv.x) * d0[1]); w.y = cvt_pk_bf16(bf_lo(pv.y) * d0[2], bf_hi(pv.y) * d0[3]);
                w.z = cvt_pk_bf16(bf_lo(pv.z) * d1[0], bf_hi(pv.z) * d1[1]); w.w = cvt_pk_bf16(bf_lo(pv.w) * d1[2], bf_hi(pv.w) * d1[3]);
                *(u32x4*)yp = w;
            }
        }
        asm volatile("" ::: "memory");
    }
#undef SP_LOAD
    __syncthreads();
}

__global__ void __launch_bounds__(NTHR, 2) mk_fwd(Params P) {
    extern __shared__ __attribute__((aligned(16))) unsigned char lds_raw[];
    LAS unsigned char* lds = (LAS unsigned char*)lds_raw;
    volatile LAS unsigned* MISC = (volatile LAS unsigned*)(lds + MISC_OFF);
    const int tid = threadIdx.x, lane = tid & 63, wave = __builtin_amdgcn_readfirstlane(tid >> 6);
    if (tid < 64) MISC[tid] = 0u;
    __syncthreads();
    unsigned char* ws = P.ws;
    XcdBarrier bar; bar.bar = (unsigned*)(ws + WS_BAR); bar.x = 0; bar.st = MISC + 8;
    if (P.hi - P.lo > 1) bar = xcd_barrier_post((unsigned*)(ws + WS_BAR), MISC + 8);
    bar.wv = wave;
#define RUN(s) (P.lo <= (s) && (s) < P.hi)
#define SEAM(s) do { if (RUN(s) && RUN((s) + 1)) xcd_barrier(bar); } while (0)
    int step = 0;
    bf16_t* YC = (bf16_t*)P.out;
    if (RUN(step)) { const int t2 = opaque_tid(wave); pre_phase(P, lds, t2, t2 & 63, wave); __syncthreads(); p0_phase(P, wave); }
    SEAM(step); ++step;
    for (int layer = 0; layer < DEPTH; ++layer) {
        const u64* ssq = (const u64*)(ws + WS_SSQ) + (size_t)layer * TP;
        if (RUN(step)) {
            {
                pg8::GOp A{(const char*)(ws + WS_XB), 2048u, 32u, 128, 0};
                pg8::GOp B{(const char*)(ws + WS_WIN) + (size_t)layer * NIN * 1024 * 2, 2048u, 32u, 128, 0};
                pg8::SchedStd S; S.init(TP, 4096, gridDim.x, opaque_bid());
                EpiInMain E{YC, (bf16_t*)(ws + WS_XS), ssq, lds};
                pg8::gemm_phase(lds, A, B, 16, S, E, wave);
            }
            {
                pg8::GOp A{(const char*)(ws + WS_WIN) + ((size_t)layer * NIN + 4096) * 1024 * 2, 2048u, 32u, 128, 0};
                pg8::GOp B{(const char*)(ws + WS_XB), 2048u, 32u, 128, 0};
                pg8::SchedStd S; S.init(1024, TP, gridDim.x, opaque_bid());
                EpiInV E{(bf16_t*)(ws + WS_GV), ssq, (u64*)(ws + WS_VSUM) + (size_t)layer * TP, (u64*)(ws + WS_VSQ) + (size_t)layer * TP, lds};
                pg8::gemm_phase(lds, A, B, 16, S, E, wave);
            }
        }
        SEAM(step); ++step;
        if (RUN(step)) {
            for (int rep = 0; rep < (64 * (NCH / 256)) / GRID; ++rep) {
                pg8::GOp A{(const char*)(ws + WS_XS), (unsigned)(XSK * 2), 32u, 128, (size_t)NCH * XSK * 2};
                pg8::GOp B{(const char*)(ws + WS_W1) + (size_t)layer * 64 * 256 * 512 * 2, 1024u, 32u, 128, (size_t)256 * 512 * 2};
                const int L = rep * GRID + opaque_bid(), nwg = 64 * (NCH / 256), w = (L % 8) * (nwg / 8) + L / 8;
                pg8::SchedOne S; S.u.g = w / (NCH / 256); S.u.pm = w % (NCH / 256); S.u.pn = 0;
                EpiS1Scan E{(bf16_t*)(ws + WS_XS), (const float*)(ws + WS_AQ) + (size_t)layer * 64 * 2 * 64 * 2};
                pg8::gemm_phase(lds, A, B, 8, S, E, wave);
            }
            spatial_phase(ws, YC, lds, layer, wave);
        }
        SEAM(step); ++step;
        if (RUN(step)) {
            pg8::GOp A{(const char*)(ws + WS_XS), (unsigned)(XSK * 2), 32u, 128, (size_t)NCH * XSK * 2};
            pg8::GOp B{(const char*)(ws + WS_W3) + (size_t)layer * 64 * 512 * XSK * 2, (unsigned)(XSK * 2), 32u, 128, (size_t)512 * XSK * 2};
            pg8::SchedBatch S; S.init(64, NCH / 256, 2, gridDim.x, opaque_bid());
            EpiBf16<1> E{(bf16_t*)(ws + WS_GV), 512, (size_t)NCH * 512, lds};
            pg8::gemm_phase(lds, A, B, 12, S, E, wave);
        }
        SEAM(step); ++step;
        if (RUN(step)) {
            pg8::GOp A{(const char*)(ws + WS_GV), 32u, (unsigned)(TP * 32), (size_t)4 * TP * 32, 0};
            pg8::GOp B{(const char*)(ws + WS_WGLU) + (size_t)layer * 1024 * 1024 * 2, 2048u, 32u, 128, 0};
            pg8::SchedStd S; S.init(TP, 1024, gridDim.x, opaque_bid());
            EpiGlu E{(const bf16_t*)(ws + WS_GV), YC, (const float*)(ws + WS_VEC) + VEC_BGLU + layer * 1024, lds};
            pg8::gemm_phase(lds, A, B, 16, S, E, wave);
        }
        SEAM(step); ++step;
        if (RUN(step)) {
            pg8::GOp A{(const char*)YC, 4096u, 32u, 128, 0};
            pg8::GOp B{(const char*)(ws + WS_WOUT) + (size_t)layer * 1024 * 2048 * 2, 4096u, 32u, 128, 0};
            pg8::SchedStd S; S.init(TP, 1024, gridDim.x, opaque_bid());
            EpiOut E{layer == 0 ? P.in[I_XP] : nullptr, P.in[I_XS], (bf16_t*)(ws + WS_XB), (u64*)(ws + WS_SSQ) + (size_t)(layer + 1) * TP, layer == DEPTH - 1 ? (float*)(ws + WS_XF) : nullptr, lds};
            pg8::gemm_phase(lds, A, B, 32, S, E, wave);
        }
        SEAM(step); ++step;
    }
    if (RUN(step)) pz_phase(P, wave);
    ++step;
#undef RUN
#undef SEAM
}

extern "C" void kernel_launch(void* const* d_in, const int* in_sizes, int n_in, void* d_out, int out_size, void* d_ws, size_t ws_size, hipStream_t stream) {
    static int ready = 0;
    if (ready == 0) {
        if (n_in != 20 || out_size != TALL * D || ws_size < WS_END) { fprintf(stderr, "kernel_launch: unexpected shapes (n_in %d, out %d, ws %zu)\n", n_in, out_size, ws_size); ready = -1; return; }
        if (hipFuncSetAttribute((const void*)mk_fwd, hipFuncAttributeMaxDynamicSharedMemorySize, LDS_BYTES) != hipSuccess) { fprintf(stderr, "kernel_launch: hipFuncSetAttribute failed\n"); ready = -1; return; }
        ready = 1;
    }
    if (ready < 0) return;
    (void)hipMemsetAsync(d_ws, 0, ZERO_BYTES, stream);
    Params p{};
    for (int i = 0; i < 20; ++i) p.in[i] = (const float*)d_in[i];
    p.out = (float*)d_out; p.ws = (unsigned char*)d_ws;
#if MK_ONE_LAUNCH
    p.lo = 0; p.hi = NSTEPS;
    hipLaunchKernelGGL(mk_fwd, dim3(GRID), dim3(NTHR), LDS_BYTES, stream, p);
#else
    for (int s = 0; s < NSTEPS; ++s) { p.lo = s; p.hi = s + 1; hipLaunchKernelGGL(mk_fwd, dim3(GRID), dim3(NTHR), LDS_BYTES, stream, p); }
#endif
}
```
